# Optimizing an MI355X kernel written in HIP

```python
import math
import jax, jax.numpy as jnp
from jax import lax
import numpy as np

D_MODEL = 2048
BATCH = 4
SEQ = 2048
DEPTH = 2

GRID_W = 64
CTX_LEN = 256
MLA_HEADS = 8
MLA_Q_RANK = 768
MLA_KV_RANK = 512
MLA_NOPE = 128
MLA_ROPE = 64
MLA_V = 128
DIFF_HEADS = 4
DIFF_HD = 64
DIFF_V = 2 * DIFF_HD
POOL_WINDOWS = (2, 4, 8, 16)
POOL_GROUP = 128
POOL_W = len(POOL_WINDOWS) * POOL_GROUP
N_BRANCH = 3
SPLIT_WIDTHS = (MLA_KV_RANK, MLA_ROPE, DIFF_HEADS * 2 * DIFF_HD, DIFF_HEADS * DIFF_V,
                MLA_Q_RANK, DIFF_HEADS * 2 * DIFF_HD, POOL_W, N_BRANCH * D_MODEL)
KV_COLS = sum(SPLIT_WIDTHS[:4])
IN_COLS = sum(SPLIT_WIDTHS)
N_GROUPS = 8
EXPERTS_PER_GROUP = 8
N_EXPERTS = N_GROUPS * EXPERTS_PER_GROUP
TOP_K = 2
D_EXPERT = 512
EXPERT_BLOCK = 128
Q_BLOCK = 128
ROPE_BASE = 10000.0
EPS = 1e-6
DN_ALPHA = (2 * DEPTH) ** 0.25
DN_BETA = (8 * DEPTH) ** -0.25

kernel_name = "hybrid_mla_diff_pool_hmoe_dit"


def split_cols(p, widths):
    offs = np.cumsum(widths)[:-1].tolist()
    return jnp.split(p, offs, axis=-1)


def layer_norm(x):
    xf = x.astype(jnp.float32)
    mu = jnp.mean(xf, axis=-1, keepdims=True)
    var = jnp.mean(jnp.square(xf - mu), axis=-1, keepdims=True)
    return ((xf - mu) * lax.rsqrt(var + EPS)).astype(x.dtype)


def rms_norm(x, g):
    xf = x.astype(jnp.float32)
    return (xf * lax.rsqrt(jnp.mean(xf * xf, axis=-1, keepdims=True) + EPS)).astype(x.dtype) * g


def modulate(x, shift, scale):
    return layer_norm(x) * (1.0 + scale) + shift


def deepnorm_residual(x, y, g, b):
    return layer_norm(DN_ALPHA * x + y) * g + b


def axial_rope_table(n_rows, rot_dim):
    quarter = rot_dim // 4
    inv_freq = ROPE_BASE ** (-jnp.arange(quarter, dtype=jnp.float32) / quarter)
    row = jnp.repeat(jnp.arange(n_rows, dtype=jnp.float32), GRID_W)
    col = (jnp.arange(n_rows * GRID_W) % GRID_W).astype(jnp.float32)
    ang = jnp.stack([row[:, None] * inv_freq, col[:, None] * inv_freq], axis=1)
    return jnp.cos(ang), jnp.sin(ang)


def apply_rope(x, cos, sin):
    r, s = x.shape[-1], x.shape[1]
    bshape = (1, s) + (1,) * (x.ndim - 3) + (2, r // 4)
    c, sn = cos.reshape(bshape), sin.reshape(bshape)
    xf = x.astype(jnp.float32).reshape(x.shape[:-1] + (2, 2, r // 4))
    x1, x2 = xf[..., 0, :], xf[..., 1, :]
    out = jnp.stack([x1 * c - x2 * sn, x2 * c + x1 * sn], axis=-2)
    return out.reshape(x.shape).astype(x.dtype)


def multi_map_attention(q, k, v, coef):
    b, sq, h, m, dk = q.shape
    nb = sq // Q_BLOCK
    scale = dk ** -0.5
    qb = jnp.moveaxis(q.reshape(b, nb, Q_BLOCK, h, m, dk), 1, 0)

    def one_block(qblk):
        s = jnp.einsum('bqhmd,bkhmd->bhmqk', qblk, k).astype(jnp.float32) * scale
        w = jnp.einsum('bhmqk,m->bhqk', jax.nn.softmax(s, axis=-1), coef)
        return jnp.einsum('bhqk,bkhd->bqhd', w.astype(v.dtype), v)

    out = lax.map(one_block, qb)
    return jnp.moveaxis(out, 0, 1).reshape(b, sq, h, v.shape[-1])


def pool_mixer(u, w_pool, pool_scale):
    b, s, _ = u.shape
    ug = u.reshape(b, s, len(POOL_WINDOWS), POOL_GROUP)
    t = jnp.arange(s)
    outs = []
    for gi, w in enumerate(POOL_WINDOWS):
        half = w // 2
        xg = ug[:, :, gi, :].astype(jnp.float32)
        xp = jnp.pad(xg, ((0, 0), (half, half), (0, 0)))
        cs = jnp.concatenate([jnp.zeros((b, 1, POOL_GROUP), jnp.float32), jnp.cumsum(xp, axis=1)], axis=1)
        win = cs[:, w:w + s] - cs[:, :s]
        cnt = (jnp.minimum(t + half, s) - jnp.maximum(t - half, 0)).astype(jnp.float32)
        outs.append(win / cnt[None, :, None] - xg)
    pooled = jnp.stack(outs, axis=2).astype(u.dtype)
    y = jnp.einsum('bsgc,gcd->bsgd', pooled, w_pool)
    return y.reshape(b, s, POOL_W) * pool_scale


def token_mixer(u_lat, u_ctx, rope_mla, rope_diff, lam_init, ctx_out,
                w_in, b_gate, g_q, g_kv, w_uq, w_ukv, lam, g_sub, w_pool, pool_scale,
                w_br_mla, w_br_diff, w_br_pool, w_o):
    lam_val = (jnp.exp(jnp.sum(lam[0] * lam[1])) - jnp.exp(jnp.sum(lam[2] * lam[3]))).astype(jnp.float32) + lam_init
    coef_mla = jnp.ones((1,), jnp.float32)
    coef_diff = jnp.stack([jnp.ones((), jnp.float32), -lam_val])

    def keys_values(p, use_rope):
        b, s = p.shape[:2]
        c_kv, k_rot, k_diff, v_diff = split_cols(p[..., :KV_COLS], SPLIT_WIDTHS[:4])
        kv = (rms_norm(c_kv, g_kv) @ w_ukv).reshape(b, s, MLA_HEADS, MLA_NOPE + MLA_V)
        k_rot = k_rot.reshape(b, s, 1, MLA_ROPE)
        k_diff = k_diff.reshape(b, s, DIFF_HEADS, 2, DIFF_HD)
        if use_rope:
            k_rot = apply_rope(k_rot, *rope_mla)
            k_diff = apply_rope(k_diff, *rope_diff)
        k_mla = jnp.concatenate([kv[..., :MLA_NOPE], jnp.broadcast_to(k_rot, (b, s, MLA_HEADS, MLA_ROPE))], axis=-1)
        return (k_mla[:, :, :, None, :], kv[..., MLA_NOPE:], k_diff, v_diff.reshape(b, s, DIFF_HEADS, DIFF_V))

    def stream_out(p, use_rope, k_mla, v_mla, k_diff, v_diff):
        b, s = p.shape[:2]
        c_q, q_diff, pool_in, gate_in = split_cols(p[..., KV_COLS:], SPLIT_WIDTHS[4:])
        q = (rms_norm(c_q, g_q) @ w_uq).reshape(b, s, MLA_HEADS, MLA_NOPE + MLA_ROPE)
        q_nope, q_rot = q[..., :MLA_NOPE], q[..., MLA_NOPE:]
        q_diff = q_diff.reshape(b, s, DIFF_HEADS, 2, DIFF_HD)
        if use_rope:
            q_rot = apply_rope(q_rot, *rope_mla)
            q_diff = apply_rope(q_diff, *rope_diff)
        q_mla = jnp.concatenate([q_nope, q_rot], axis=-1)[:, :, :, None, :]
        o_mla = multi_map_attention(q_mla, k_mla, v_mla, coef_mla).reshape(b, s, MLA_HEADS * MLA_V)
        o_diff = multi_map_attention(q_diff, k_diff, v_diff, coef_diff)
        o_diff = (rms_norm(o_diff, g_sub) * (1.0 - lam_init)).reshape(b, s, DIFF_HEADS * DIFF_V)
        o_pool = pool_mixer(pool_in, w_pool, pool_scale)
        gates = jax.nn.sigmoid(gate_in.reshape(b, s, N_BRANCH, D_MODEL) + b_gate)
        merged = (gates[:, :, 0] * (o_mla @ w_br_mla)
                  + gates[:, :, 1] * (o_diff @ w_br_diff)
                  + gates[:, :, 2] * (o_pool @ w_br_pool))
        return merged @ w_o

    p_lat = u_lat @ w_in
    p_ctx = u_ctx @ (w_in if ctx_out else w_in[:, :KV_COLS])
    kv_lat = keys_values(p_lat, True)
    kv_ctx = keys_values(p_ctx, False)
    kv_all = tuple(jnp.concatenate([kc, kl], axis=1) for kc, kl in zip(kv_ctx, kv_lat))
    out_lat = stream_out(p_lat, True, *kv_all)
    out_ctx = stream_out(p_ctx, False, *kv_ctx) if ctx_out else None
    return out_lat, out_ctx


def expert_ffn(h, expert_idx, weights, w_gu, w_dn):
    n_tok, d = h.shape
    n_assign = n_tok * TOP_K
    flat_e = expert_idx.reshape(n_assign)
    order = jnp.argsort(flat_e)
    sorted_e = flat_e[order]
    sorted_tok = (order // TOP_K).astype(jnp.int32)
    sorted_w = weights.reshape(n_assign)[order]
    counts = jnp.bincount(flat_e, length=N_EXPERTS)
    padded = (counts + EXPERT_BLOCK - 1) // EXPERT_BLOCK * EXPERT_BLOCK
    pad_end = jnp.cumsum(padded)
    pad_start = pad_end - padded
    start = jnp.cumsum(counts) - counts
    dest = pad_start[sorted_e] + jnp.arange(n_assign) - start[sorted_e]
    n_blocks = -(-(n_assign + N_EXPERTS * (EXPERT_BLOCK - 1)) // EXPERT_BLOCK)
    n_rows = n_blocks * EXPERT_BLOCK
    slot_tok = jnp.full((n_rows,), n_tok, jnp.int32).at[dest].set(sorted_tok)
    slot_w = jnp.zeros((n_rows,), jnp.float32).at[dest].set(sorted_w)
    block_exp = jnp.minimum(jnp.searchsorted(pad_end, jnp.arange(n_blocks) * EXPERT_BLOCK, side='right'),
                            N_EXPERTS - 1)
    h_pad = jnp.concatenate([h, jnp.zeros((1, d), h.dtype)], axis=0)
    xb = h_pad[slot_tok].reshape(n_blocks, EXPERT_BLOCK, d)

    def run_block(args):
        xblk, e = args
        gate, up = jnp.split(xblk @ w_gu[e], 2, axis=-1)
        return (jax.nn.silu(gate) * up) @ w_dn[e]

    yb = lax.map(run_block, (xb, block_exp))
    y = yb.reshape(n_rows, d) * slot_w[:, None].astype(h.dtype)
    return jnp.zeros((n_tok + 1, d), h.dtype).at[slot_tok].add(y)[:n_tok]


def hierarchical_moe(h, w_grp, b_grp, w_exp, b_exp, w_gu, w_dn):
    n_tok = h.shape[0]
    grp_prob = jax.nn.softmax((h @ w_grp + b_grp).astype(jnp.float32), axis=-1)
    grp_p, grp_idx = lax.top_k(grp_prob, 1)
    exp_logits = (h @ w_exp + b_exp).astype(jnp.float32).reshape(n_tok, N_GROUPS, EXPERTS_PER_GROUP)
    in_grp = exp_logits[jnp.arange(n_tok), grp_idx[:, 0]]
    top_val, top_loc = lax.top_k(in_grp, TOP_K)
    weights = jax.nn.softmax(top_val, axis=-1) * grp_p
    expert_idx = grp_idx * EXPERTS_PER_GROUP + top_loc
    return expert_ffn(h, expert_idx, weights, w_gu, w_dn)


def setup_inputs(seed: int = 0) -> dict:
    key = jax.random.key(seed)
    ks = iter(jax.random.split(key, 40))
    D, L = D_MODEL, DEPTH

    def nrm(shape, scale):
        return jax.random.normal(next(ks), shape, jnp.float32) * scale

    return {
        "x": nrm((BATCH, SEQ, D), 1.0),
        "c": nrm((BATCH, D), 1.0),
        "ctx": nrm((BATCH, CTX_LEN, D), 1.0),
        "c_ctx": nrm((D,), 1.0),
        "w_ada": nrm((L, D, 6 * D), 0.5 * D ** -0.5),
        "b_ada": nrm((L, 6 * D), 0.01),
        "w_in": nrm((L, D, IN_COLS), D ** -0.5),
        "b_gate": nrm((L, N_BRANCH, D), 0.01),
        "g_q": 1.0 + nrm((L, MLA_Q_RANK), 0.01),
        "g_kv": 1.0 + nrm((L, MLA_KV_RANK), 0.01),
        "w_uq": nrm((L, MLA_Q_RANK, MLA_HEADS * (MLA_NOPE + MLA_ROPE)), MLA_Q_RANK ** -0.5),
        "w_ukv": nrm((L, MLA_KV_RANK, MLA_HEADS * (MLA_NOPE + MLA_V)), MLA_KV_RANK ** -0.5),
        "lam": nrm((L, 4, DIFF_HD), 0.1),
        "g_sub": 1.0 + nrm((L, DIFF_V), 0.01),
        "w_pool": nrm((L, len(POOL_WINDOWS), POOL_GROUP, POOL_GROUP), POOL_GROUP ** -0.5),
        "pool_scale": 1.0 + nrm((L, POOL_W), 0.01),
        "w_br_mla": nrm((L, MLA_HEADS * MLA_V, D), (MLA_HEADS * MLA_V) ** -0.5),
        "w_br_diff": nrm((L, DIFF_HEADS * DIFF_V, D), (DIFF_HEADS * DIFF_V) ** -0.5),
        "w_br_pool": nrm((L, POOL_W, D), POOL_W ** -0.5),
        "w_o": nrm((L, D, D), DN_BETA * D ** -0.5),
        "ln1_g": 1.0 + nrm((L, D), 0.01),
        "ln1_b": nrm((L, D), 0.01),
        "w_grp": nrm((L, D, N_GROUPS), D ** -0.5),
        "b_grp": nrm((L, N_GROUPS), 0.01),
        "w_exp": nrm((L, D, N_EXPERTS), D ** -0.5),
        "b_exp": nrm((L, N_EXPERTS), 0.01),
        "w_gu": nrm((L, N_EXPERTS, D, 2 * D_EXPERT), D ** -0.5),
        "w_dn": nrm((L, N_EXPERTS, D_EXPERT, D), DN_BETA * D_EXPERT ** -0.5),
        "ln2_g": 1.0 + nrm((L, D), 0.01),
        "ln2_b": nrm((L, D), 0.01),
    }


def reference(x, c, ctx, c_ctx, w_ada, b_ada, w_in, b_gate, g_q, g_kv, w_uq, w_ukv, lam, g_sub,
              w_pool, pool_scale, w_br_mla, w_br_diff, w_br_pool, w_o, ln1_g, ln1_b,
              w_grp, b_grp, w_exp, b_exp, w_gu, w_dn, ln2_g, ln2_b):
    n_lat = x.shape[1]
    rows = n_lat // GRID_W
    rope_mla = axial_rope_table(rows, MLA_ROPE)
    rope_diff = axial_rope_table(rows, DIFF_HD)
    x_lat, x_ctx = x, ctx
    for l in range(DEPTH):
        last = l == DEPTH - 1
        lam_init = 0.8 - 0.6 * math.exp(-0.3 * l)
        sh1, sc1, g1, sh2, sc2, g2 = jnp.split(jax.nn.silu(c) @ w_ada[l] + b_ada[l], 6, axis=-1)
        csh1, csc1, cg1, csh2, csc2, cg2 = jnp.split(jax.nn.silu(c_ctx) @ w_ada[l] + b_ada[l], 6, axis=-1)

        u_lat = modulate(x_lat, sh1[:, None], sc1[:, None])
        u_ctx = modulate(x_ctx, csh1, csc1)
        m_lat, m_ctx = token_mixer(u_lat, u_ctx, rope_mla, rope_diff, lam_init, not last,
                                   w_in[l], b_gate[l], g_q[l], g_kv[l], w_uq[l], w_ukv[l], lam[l], g_sub[l],
                                   w_pool[l], pool_scale[l], w_br_mla[l], w_br_diff[l], w_br_pool[l], w_o[l])
        x_lat = deepnorm_residual(x_lat, g1[:, None] * m_lat, ln1_g[l], ln1_b[l])
        if not last:
            x_ctx = deepnorm_residual(x_ctx, cg1 * m_ctx, ln1_g[l], ln1_b[l])

        b, s, d = x_lat.shape
        v_lat = modulate(x_lat, sh2[:, None], sc2[:, None]).reshape(b * s, d)
        if last:
            y_lat = hierarchical_moe(v_lat, w_grp[l], b_grp[l], w_exp[l], b_exp[l], w_gu[l], w_dn[l])
        else:
            v_ctx = modulate(x_ctx, csh2, csc2).reshape(-1, d)
            y = hierarchical_moe(jnp.concatenate([v_lat, v_ctx], axis=0),
                                 w_grp[l], b_grp[l], w_exp[l], b_exp[l], w_gu[l], w_dn[l])
            y_lat = y[:b * s]
            x_ctx = deepnorm_residual(x_ctx, cg2 * y[b * s:].reshape(x_ctx.shape), ln2_g[l], ln2_b[l])
        x_lat = deepnorm_residual(x_lat, g2[:, None] * y_lat.reshape(b, s, d), ln2_g[l], ln2_b[l])
    return x_lat
```

```cpp
#include <hip/hip_runtime.h>
#include <cstdio>
#include <cstdint>

#ifndef MK_N_LAUNCHES
#define MK_N_LAUNCHES 1
#endif

#define GAS __attribute__((address_space(1)))
#define LAS __attribute__((address_space(3)))
typedef unsigned short bf16_t;
typedef short bf16x8 __attribute__((ext_vector_type(8)));
typedef short s16x4 __attribute__((ext_vector_type(4)));
typedef float f32x4 __attribute__((ext_vector_type(4)));
typedef float f32x16 __attribute__((ext_vector_type(16)));
typedef unsigned u32x4 __attribute__((ext_vector_type(4)));
typedef unsigned u32x2 __attribute__((ext_vector_type(2)));
typedef GAS bf16_t GB; typedef GAS float GF; typedef GAS int GI; typedef GAS unsigned GU; typedef GAS unsigned char GC;
typedef GAS f32x4 Gf32x4; typedef GAS u32x4 Gu32x4; typedef GAS u32x2 Gu32x2; typedef GAS bf16x8 Gbf16x8;
typedef __attribute__((address_space(4))) const unsigned char CKA;

constexpr int D = 2048, NB = 4, SEQ = 2048, CTX = 256, NL = 2;
constexpr int TL = NB * SEQ, TC = NB * CTX, T = TL + TC;
constexpr int NP = 9728;
constexpr int IN_COLS = 9536;
constexpr int NEXP = 64, DEXP = 512;
constexpr int STROWS = 384, MAXST = 112, MAXSLOTS = MAXST * 512;
constexpr float EPS = 1e-6f;
constexpr float DN_ALPHA = 1.4142135623730951f;
constexpr float LOG2E = 1.4426950408889634f;

__device__ __forceinline__ unsigned f2bf(float f) { unsigned u = __builtin_bit_cast(unsigned, f); return (u + 0x7fffu + ((u >> 16) & 1u)) >> 16; }
__device__ __forceinline__ unsigned pk2(float lo, float hi) { return f2bf(lo) | (f2bf(hi) << 16); }
__device__ __forceinline__ float bf2f(unsigned short b) { return __builtin_bit_cast(float, ((unsigned)b) << 16); }
__device__ __forceinline__ float bflo(unsigned w) { return __builtin_bit_cast(float, w << 16); }
__device__ __forceinline__ float bfhi(unsigned w) { return __builtin_bit_cast(float, w & 0xffff0000u); }
typedef float f32x2_t __attribute__((ext_vector_type(2)));
typedef __bf16 bf16x2_t __attribute__((ext_vector_type(2)));
__device__ __forceinline__ unsigned cvt_pk_bf16(float lo, float hi) { f32x2_t v = {lo, hi}; bf16x2_t b = __builtin_convertvector(v, bf16x2_t); return __builtin_bit_cast(unsigned, b); }
__device__ __forceinline__ void st4bf(GB* p, f32x4 v) { u32x2 w; w.x = cvt_pk_bf16(v[0], v[1]); w.y = cvt_pk_bf16(v[2], v[3]); *(Gu32x2*)p = w; }
__device__ __forceinline__ f32x4 ld4bf(const GB* p) { const u32x2 w = *(const Gu32x2*)p; return (f32x4){bflo(w.x), bfhi(w.x), bflo(w.y), bfhi(w.y)}; }
__device__ __forceinline__ unsigned enc16(float x) { const unsigned u = __builtin_bit_cast(unsigned, x), m = (u & 0x7fffffffu) + (1u << 13); int t = (int)(m >> 14) - (96 << 9); t = t < 0 ? 0 : (t > 0x7fff ? 0x7fff : t); return ((u >> 16) & 0x8000u) | (unsigned)t; }
__device__ __forceinline__ float dec16(unsigned h) { const unsigned a = h & 0x7fffu; const unsigned f = ((h & 0x8000u) << 16) | ((a + (96u << 9)) << 14); return a ? __builtin_bit_cast(float, f) : 0.f; }
__device__ __forceinline__ void st4h(GB* p, f32x4 v) { u32x2 w; w.x = enc16(v[0]) | (enc16(v[1]) << 16); w.y = enc16(v[2]) | (enc16(v[3]) << 16); *(Gu32x2*)p = w; }
__device__ __forceinline__ f32x4 ld4h(const GB* p) { const u32x2 w = *(const Gu32x2*)p; return (f32x4){dec16(w.x & 0xffffu), dec16(w.x >> 16), dec16(w.y & 0xffffu), dec16(w.y >> 16)}; }
__device__ __forceinline__ float wave_sum(float v) {
#pragma unroll
    for (int o = 1; o < 64; o <<= 1) v += __shfl_xor(v, o);
    return v;
}

namespace pg8 {
constexpr int BM = 256, BK = 64, HALF = 128, HTB = HALF * BK * 2, STAGE_BYTES = 8 * HTB, NXCD = 8, WGM = 8;
__host__ __device__ __forceinline__ int lds_byte(int r, int c) { const int st = (r >> 4) * 2 + (c >> 5), rr = r & 15, cc = c & 31, ob = rr * 64 + cc * 2; return st * 1024 + (ob ^ (((ob >> 9) & 1) << 5)); }
__host__ __device__ __forceinline__ void stage_rc(int b, int& R, int& C) { const int st = b / 1024, sb = b % 1024, swz = sb ^ (((sb >> 9) & 1) << 5); R = (st >> 1) * 16 + swz / 64; C = (st & 1) * 32 + (swz % 64) / 2; }

struct Unit { int pm, pn, ex; };

struct Plain {
    const GB* A; const GB* Bt; int K, lda, ldb; static constexpr int kstepB = BK * 2;
    __device__ __forceinline__ const GAS char* aptr(const Unit& u) const { return (const GAS char*)(A + (size_t)u.pm * BM * lda); }
    __device__ __forceinline__ const GAS char* bptr(const Unit& u) const { return (const GAS char*)(Bt + (size_t)u.pn * BM * ldb); }
};
struct Grouped {
    const GB* A; const GB* Bt; int K, lda; size_t estride; static constexpr int ldb = 64, kstepB = 256 * 64 * 2;
    __device__ __forceinline__ const GAS char* aptr(const Unit& u) const { return (const GAS char*)(A + (size_t)u.pm * BM * lda); }
    __device__ __forceinline__ const GAS char* bptr(const Unit& u) const { return (const GAS char*)(Bt + (size_t)u.ex * estride + (size_t)u.pn * (K / 64) * 256 * 64); }
};

struct RectOrder {
    int nM, nN, nwg, G, c, pm0b, nMb, nNb, nwgb, rot, rot0;
    __device__ void init(int nM_, int nN_, int G_, int c_, int pm0b_ = 0, int nMb_ = 0, int nNb_ = 0) { nM = nM_; nN = nN_; nwg = nM * nN; G = G_; c = c_; pm0b = pm0b_; nMb = nMb_; nNb = nNb_; nwgb = nMb * nNb; rot = 0; rot0 = 0; }
    __device__ bool next(int i, Unit& u) const {
        const int L = i * G + (c - (i == 0 ? rot0 : rot) + G) % G; u.ex = i == 0 ? 0 : 1 + (L - G);
        if (L < nwg) {
            int wgid = L; { const int q = nwg / NXCD, r = nwg % NXCD, xcd = wgid % NXCD, off = wgid / NXCD; wgid = (xcd < r ? xcd * (q + 1) : r * (q + 1) + (xcd - r) * q) + off; }
            const int nig = WGM * nN, gid = wgid / nig, fm = gid * WGM, gsz = (nM - fm) < WGM ? (nM - fm) : WGM;
            u.pm = fm + ((wgid % nig) % gsz); u.pn = (wgid % nig) / gsz; return true;
        }
        const int L2 = L - nwg; if (L2 >= nwgb) return false;
        u.pm = pm0b + L2 % nMb; u.pn = L2 / nMb; return true;
    }
};
struct TileOrder {
    const GI* te; int ntiles, nN, G, c;
    __device__ bool next(int i, Unit& u) const {
        const int tpr = G / nN;
        int tl, pn;
        if ((G & 7) == 0 && (tpr & 7) == 0) { const int x = c & 7, sl = c >> 3; tl = x * (tpr >> 3) + sl / nN; pn = sl % nN; }
        else { tl = c / nN; pn = c % nN; if (tl >= tpr) return false; }
        const int pm = i * tpr + tl; if (pm >= ntiles) return false;
        u.pm = pm; u.pn = pn; u.ex = __hip_atomic_load(te + pm, __ATOMIC_RELAXED, __HIP_MEMORY_SCOPE_AGENT); return true;
    }
};

template <class Prob, class Epi, class Sched, bool ALIGN_EPI = true, bool SP2 = true>
__device__ __forceinline__ void gemm_phase_stream(LAS unsigned char* lds, const Prob g, const Sched& S, const Epi& E) {
    int tid_ = threadIdx.x; asm volatile("" : "+v"(tid_));
    const int tid = tid_, wid = __builtin_amdgcn_readfirstlane(tid >> 6), lane = tid & 63, wr = wid >> 2, wc = wid & 3, fr = lane & 15, fq = lane >> 4;
    const int K = g.K, nt = K / BK;
    unsigned voffA[2], voffB[2];
#pragma unroll
    for (int i = 0; i < 2; ++i) { int R, C; stage_rc(tid * 16 + i * 8192, R, C); voffA[i] = (unsigned)(R * g.lda + C) * 2u; voffB[i] = (unsigned)(R * g.ldb + C) * 2u; }
    const size_t kstep = (size_t)(BK * 2), kstepB = (size_t)g.kstepB;
    const size_t hstepA = (size_t)HALF * g.lda * 2, hstepB = (size_t)HALF * g.ldb * 2;
    const unsigned ldsw = (unsigned)wid * 1024u;
    const int aoff = lds_byte(wr * 64 + fr, fq * 8), boff = lds_byte(wc * 32 + fr, fq * 8);
#define PG8_SA(b, h) (((b) * 2 + (h)) * HTB)
#define PG8_SB(b, h) ((4 + (b) * 2 + (h)) * HTB)
#define PG8_STAGE(bufoff, gbase, voff) do { _Pragma("unroll") for (int _i = 0; _i < 2; ++_i) \
        __builtin_amdgcn_global_load_lds((const unsigned*)((const GAS char*)(gbase) + (voff)[_i]), (LAS unsigned*)(lds + (bufoff) + ldsw + _i * 8192), 16, 0, 0); } while (0)
#define PG8_LDA(dst, b, h) do { _Pragma("unroll") for (int m = 0; m < 4; ++m) _Pragma("unroll") for (int k = 0; k < 2; ++k) dst[m][k] = *(const LAS bf16x8*)(lds + PG8_SA(b, h) + aoff + m * 2048 + k * 1024); } while (0)
#define PG8_LDB(dst, b, h) do { _Pragma("unroll") for (int n = 0; n < 2; ++n) _Pragma("unroll") for (int k = 0; k < 2; ++k) dst[n][k] = *(const LAS bf16x8*)(lds + PG8_SB(b, h) + boff + n * 2048 + k * 1024); } while (0)
#define PG8_MMA(ai, bj, At, Bt) do { __builtin_amdgcn_s_setprio(1); _Pragma("unroll") for (int m = 0; m < 4; ++m) _Pragma("unroll") for (int n = 0; n < 2; ++n) _Pragma("unroll") for (int k = 0; k < 2; ++k) \
        acc[ai][bj][m][n] = __builtin_amdgcn_mfma_f32_16x16x32_bf16(Bt[n][k], At[m][k], acc[ai][bj][m][n], 0, 0, 0); __builtin_amdgcn_s_setprio(0); } while (0)
#define PG8_WAIT_V(n) asm volatile("s_waitcnt vmcnt(" #n ")" ::: "memory")
#define PG8_WAIT_L(n) asm volatile("s_waitcnt lgkmcnt(" #n ")" ::: "memory")
#define PG8_BAR __builtin_amdgcn_s_barrier()
#define PG8_SCHED __builtin_amdgcn_sched_barrier(0)
    Unit cur, nxt; int ui = 0;
    if (!S.next(0, cur)) return;
    f32x4 acc[2][2][4][2];
#pragma unroll
    for (int a = 0; a < 2; ++a)
#pragma unroll
        for (int b = 0; b < 2; ++b)
#pragma unroll
            for (int m = 0; m < 4; ++m)
#pragma unroll
                for (int n = 0; n < 2; ++n) acc[a][b][m][n] = (f32x4){0.f, 0.f, 0.f, 0.f};
    bf16x8 At[4][2], B0[2][2], B1[2][2];
    const GAS char* cA = g.aptr(cur); const GAS char* cB = g.bptr(cur);
    if constexpr (SP2) {
        PG8_STAGE(PG8_SB(0, 0), cB, voffB); PG8_STAGE(PG8_SB(0, 1), cB + hstepB, voffB); PG8_STAGE(PG8_SA(0, 0), cA, voffA); PG8_STAGE(PG8_SA(0, 1), cA + hstepA, voffA);
        if (wr == 1) PG8_BAR;
        PG8_WAIT_V(2); PG8_BAR;
        PG8_STAGE(PG8_SB(1, 0), cB + kstepB, voffB); PG8_STAGE(PG8_SA(1, 0), cA + kstep, voffA); PG8_STAGE(PG8_SB(1, 1), cB + hstepB + kstepB, voffB);
        PG8_WAIT_V(6); PG8_BAR;
    } else {
        PG8_STAGE(PG8_SB(0, 0), cB, voffB); PG8_STAGE(PG8_SA(0, 0), cA, voffA); PG8_STAGE(PG8_SB(0, 1), cB + hstepB, voffB); PG8_STAGE(PG8_SA(0, 1), cA + hstepA, voffA);
        if (wr == 1) PG8_BAR;
        PG8_WAIT_V(4); PG8_BAR;
        PG8_STAGE(PG8_SB(1, 0), cB + kstepB, voffB); PG8_STAGE(PG8_SA(1, 0), cA + kstep, voffA); PG8_STAGE(PG8_SB(1, 1), cB + hstepB + kstepB, voffB);
        PG8_WAIT_V(6); PG8_BAR;
    }
    for (;;) {
        const bool has_next = S.next(ui + 1, nxt);
        const GAS char* nA = has_next ? g.aptr(nxt) : cA; const GAS char* nB = has_next ? g.bptr(nxt) : cB;
        for (int t = 0; t < nt; t += 2) {
            const bool last = (t == nt - 2);
            const GAS char* a1 = cA + (size_t)(t + 1) * kstep;
            const GAS char* a2 = last ? nA : cA + (size_t)(t + 2) * kstep; const GAS char* b2 = last ? nB : cB + (size_t)(t + 2) * kstepB;
            const GAS char* a3 = a2 + kstep; const GAS char* b3 = b2 + kstepB;
            if constexpr (SP2) {
            PG8_LDB(B0, 0, 0); PG8_LDB(B1, 0, 1); PG8_SCHED; PG8_LDA(At, 0, 0); PG8_STAGE(PG8_SA(1, 1), a1 + hstepA, voffA);
            PG8_WAIT_V(8); PG8_WAIT_L(0); PG8_BAR; PG8_MMA(0, 0, At, B0); PG8_MMA(0, 1, At, B1); PG8_BAR; PG8_SCHED;
            PG8_LDA(At, 0, 1); PG8_STAGE(PG8_SB(0, 0), b2, voffB); PG8_STAGE(PG8_SB(0, 1), b2 + hstepB, voffB); PG8_STAGE(PG8_SA(0, 0), a2, voffA);
            PG8_WAIT_V(8); PG8_WAIT_L(0); PG8_BAR; PG8_MMA(1, 0, At, B0); PG8_MMA(1, 1, At, B1); PG8_BAR; PG8_SCHED;
            PG8_LDB(B0, 1, 0); PG8_LDB(B1, 1, 1); PG8_SCHED; PG8_LDA(At, 1, 0); PG8_STAGE(PG8_SA(0, 1), a2 + hstepA, voffA);
            PG8_WAIT_V(8); PG8_WAIT_L(0); PG8_BAR; PG8_MMA(0, 0, At, B0); PG8_MMA(0, 1, At, B1); PG8_BAR; PG8_SCHED;
            PG8_LDA(At, 1, 1); PG8_STAGE(PG8_SB(1, 0), b3, voffB); PG8_STAGE(PG8_SB(1, 1), b3 + hstepB, voffB); PG8_STAGE(PG8_SA(1, 0), a3, voffA);
            PG8_WAIT_V(8); PG8_WAIT_L(0); PG8_BAR; PG8_MMA(1, 0, At, B0); PG8_MMA(1, 1, At, B1); PG8_BAR; PG8_SCHED;
            } else {
            PG8_LDB(B0, 0, 0); PG8_SCHED; PG8_LDA(At, 0, 0); PG8_STAGE(PG8_SA(1, 1), a1 + hstepA, voffA);
            PG8_WAIT_L(8); PG8_BAR; PG8_WAIT_L(0); PG8_MMA(0, 0, At, B0); PG8_BAR; PG8_SCHED;
            PG8_LDB(B1, 0, 1); PG8_STAGE(PG8_SB(0, 0), b2, voffB);
            PG8_BAR; PG8_WAIT_L(0); PG8_MMA(0, 1, At, B1); PG8_BAR;
            PG8_LDA(At, 0, 1); PG8_STAGE(PG8_SA(0, 0), a2, voffA);
            PG8_BAR; PG8_WAIT_L(0); PG8_MMA(1, 0, At, B0); PG8_BAR; PG8_SCHED;
            PG8_STAGE(PG8_SB(0, 1), b2 + hstepB, voffB);
            PG8_WAIT_V(6); PG8_BAR; PG8_MMA(1, 1, At, B1); PG8_BAR;
            PG8_LDB(B0, 1, 0); PG8_SCHED; PG8_LDA(At, 1, 0); PG8_STAGE(PG8_SA(0, 1), a2 + hstepA, voffA);
            PG8_WAIT_L(8); PG8_BAR; PG8_WAIT_L(0); PG8_MMA(0, 0, At, B0); PG8_BAR; PG8_SCHED;
            PG8_LDB(B1, 1, 1); PG8_STAGE(PG8_SB(1, 0), b3, voffB);
            PG8_BAR; PG8_WAIT_L(0); PG8_MMA(0, 1, At, B1); PG8_BAR;
            PG8_LDA(At, 1, 1); PG8_STAGE(PG8_SA(1, 0), a3, voffA);
            PG8_BAR; PG8_WAIT_L(0); PG8_MMA(1, 0, At, B0); PG8_BAR; PG8_SCHED;
            PG8_STAGE(PG8_SB(1, 1), b3 + hstepB, voffB);
            PG8_WAIT_V(6); PG8_BAR; PG8_MMA(1, 1, At, B1); PG8_BAR;
            }
        }
        if constexpr (ALIGN_EPI) { if (wr == 0) PG8_BAR; }
        { int fr2 = fr, fq2 = fq; asm volatile("" : "+v"(fr2), "+v"(fq2)); E(acc, cur, wr, wc, fr2, fq2); }
        if (!has_next) break;
#pragma unroll
        for (int a = 0; a < 2; ++a)
#pragma unroll
            for (int b = 0; b < 2; ++b)
#pragma unroll
                for (int m = 0; m < 4; ++m)
#pragma unroll
                    for (int n = 0; n < 2; ++n) acc[a][b][m][n] = (f32x4){0.f, 0.f, 0.f, 0.f};
        cur = nxt; cA = nA; cB = nB; ++ui;
        if constexpr (ALIGN_EPI) { if (wr == 1) PG8_BAR; }
    }
    PG8_WAIT_V(0);
    if constexpr (!ALIGN_EPI) { if (wr == 0) PG8_BAR; }
    PG8_BAR;
#undef PG8_SA
#undef PG8_SB
#undef PG8_STAGE
#undef PG8_LDA
#undef PG8_LDB
#undef PG8_MMA
#undef PG8_WAIT_V
#undef PG8_WAIT_L
#undef PG8_BAR
#undef PG8_SCHED
}

struct OneUnit { Unit u; __device__ bool next(int i, Unit& o) const { if (i) return false; o = u; return true; } };
template <class Prob, class Epi, class Sched>
__device__ __forceinline__ void gemm_phase(LAS unsigned char* lds, const Prob g, const Sched& S, const Epi& E) {
#if defined(DBG_ONE_UNIT)
    Unit u; for (int i = 0; S.next(i, u); ++i) { OneUnit O{u}; gemm_phase_stream<Prob, Epi, OneUnit>(lds, g, O, E); }
#else
    gemm_phase_stream<Prob, Epi, Sched>(lds, g, S, E);
#endif
}
}
using pg8::Unit;
typedef const f32x4 (&AccRef)[2][2][4][2];

constexpr size_t al256(size_t x) { return (x + 255) / 256 * 256; }
constexpr size_t WS_CTL = 0, CTL_BYTES = 1u << 20;
constexpr int CW_BAR = 4096;
constexpr int CW_FLG = 20480;
constexpr int CW_CNT = 16384;
constexpr int CW_HIST = 32768;
constexpr size_t WS_MOD = WS_CTL + CTL_BYTES;
constexpr size_t WS_ROPE = WS_MOD + al256((size_t)NL * 5 * 12288 * 4);
constexpr size_t WS_WRT = WS_ROPE + 8192;
constexpr size_t WS_TE = WS_WRT + (size_t)NL * 2 * 256 * 2048 * 2;
constexpr size_t WS_WIN = WS_TE + 4096;
constexpr size_t WS_WUKV = WS_WIN + (size_t)NL * NP * 2048 * 2;
constexpr size_t WS_WUQ = WS_WUKV + (size_t)NL * 2048 * 512 * 2;
constexpr size_t WS_WPL = WS_WUQ + (size_t)NL * 1536 * 768 * 2;
constexpr size_t WS_WBM = WS_WPL + (size_t)NL * 512 * 512 * 2;
constexpr size_t WS_WBD = WS_WBM + (size_t)NL * 2048 * 1024 * 2;
constexpr size_t WS_WBP = WS_WBD + (size_t)NL * 2048 * 512 * 2;
constexpr size_t WS_WO = WS_WBP + (size_t)NL * 2048 * 512 * 2;
constexpr size_t WS_XS = WS_WO + (size_t)NL * 2048 * 2048 * 2;
constexpr size_t WS_U = WS_XS + (size_t)T * 2048 * 4;
constexpr size_t WS_CKV = WS_U + (size_t)T * 2048 * 2;
constexpr size_t WS_KD = WS_CKV + (size_t)T * 512 * 2;
constexpr size_t WS_VD = WS_KD + (size_t)T * 512 * 2;
constexpr size_t WS_KR = WS_VD + (size_t)T * 512 * 2;
constexpr size_t WS_CQ = WS_KR + (size_t)T * 64 * 2;
constexpr size_t WS_QD = WS_CQ + (size_t)T * 768 * 2;
constexpr size_t WS_PIN = WS_QD + (size_t)T * 512 * 2;
constexpr size_t WS_GT = WS_PIN + (size_t)T * 512 * 2;
constexpr size_t WS_SSQKV = WS_GT + (size_t)T * 6144 * 2;
constexpr size_t WS_SSQQ = WS_SSQKV + (size_t)T * 8 * 4;
constexpr size_t WS_KN = WS_SSQQ + al256((size_t)T * 12 * 4);
constexpr size_t WS_VM = WS_KN + (size_t)T * 1024 * 2;
constexpr size_t WS_QM = WS_VM + (size_t)T * 1024 * 2;
constexpr size_t WS_PL = WS_QM + (size_t)T * 1536 * 2;
constexpr size_t WS_OP = WS_PL + (size_t)T * 512 * 2;
constexpr size_t WS_OM = WS_OP + (size_t)T * 512 * 2;
constexpr size_t WS_OD = WS_OM + (size_t)T * 1024 * 2;
constexpr size_t WS_MG = WS_OD + (size_t)T * 512 * 2;
constexpr size_t WS_VB = WS_MG + (size_t)T * 2048 * 2;
constexpr size_t WS_TOPK = WS_VB + (size_t)T * 2048 * 2;
constexpr size_t WS_XG = WS_TOPK + (size_t)T * 32;
constexpr size_t WS_HB = WS_XG + (size_t)MAXSLOTS * 2048 * 2;
constexpr size_t WS_YB = WS_HB + (size_t)MAXSLOTS * 512 * 2;
constexpr size_t WS_VLO = WS_YB + (size_t)MAXSLOTS * 2048 * 2;
constexpr size_t WS_RP = WS_VLO + (size_t)T * 2048 * 2;
constexpr size_t WS_END = WS_RP + (size_t)6 * T * 80 * 4;

struct EpiIn {
    GC* wsb; const GF* bgate;
    __device__ __forceinline__ void operator()(AccRef acc, const Unit& u, int wr, int wc, int fr, int fq) const {
        unsigned wlo_ = (unsigned)(size_t)wsb, whi_ = (unsigned)((size_t)wsb >> 32); asm volatile("" : "+v"(wlo_), "+v"(whi_));
        GC* w_ = (GC*)(((size_t)(unsigned)__builtin_amdgcn_readfirstlane(whi_) << 32) | (size_t)(unsigned)__builtin_amdgcn_readfirstlane(wlo_));
        GB*CKV = (GB*)(w_ + WS_CKV), *KD = (GB*)(w_ + WS_KD), *VD = (GB*)(w_ + WS_VD), *KR = (GB*)(w_ + WS_KR), *CQ = (GB*)(w_ + WS_CQ), *QD = (GB*)(w_ + WS_QD), *PIN = (GB*)(w_ + WS_PIN), *GT = (GB*)(w_ + WS_GT);
        GF*SSQKV = (GF*)(w_ + WS_SSQKV), *SSQQ = (GF*)(w_ + WS_SSQQ); const GF*ropec = (const GF*)(w_ + WS_ROPE), *ropes = ropec + 1024;
        const int pn = u.pn, row0 = u.pm * 256 + wr * 64 + fr, cw = wc * 32 + 4 * fq;
        const bool lat = u.pm < 32;
        if (pn < 2 || (pn >= 7 && pn < 10)) {
            const bool iskv = pn < 2; const int t0 = iskv ? pn : pn - 7; GB* dst = iskv ? CKV : CQ; const int ldd = iskv ? 512 : 768;
            GF* ssq = iskv ? SSQKV : SSQQ; const int nss = iskv ? 8 : 12;
#pragma unroll
            for (int ai = 0; ai < 2; ++ai)
#pragma unroll
                for (int m = 0; m < 4; ++m) { const int row = row0 + ai * 128 + m * 16; float s = 0.f;
#pragma unroll
                    for (int bj = 0; bj < 2; ++bj)
#pragma unroll
                        for (int n = 0; n < 2; ++n) { const f32x4 v = acc[ai][bj][m][n]; s += (v[0] * v[0] + v[1] * v[1]) + (v[2] * v[2] + v[3] * v[3]);
                            st4bf(dst + (size_t)row * ldd + t0 * 256 + bj * 128 + cw + 16 * n, v); }
                    s += __shfl_xor(s, 16); s += __shfl_xor(s, 32);
                    if (fq == 0) ssq[(size_t)row * nss + t0 * 4 + wc] = s; }
        } else if (pn < 4 || pn == 6 || (pn >= 10 && pn < 12)) {
            if (pn == 6 && wc >= 2) return;
            const int half = wc & 1;
            GB* dst; int ldd, c0;
            if (pn < 4) { dst = KD; ldd = 512; c0 = (pn - 2) * 256; } else if (pn == 6) { dst = KR; ldd = 64; c0 = 0; } else { dst = QD; ldd = 512; c0 = (pn - 10) * 256; }
#pragma unroll
            for (int ai = 0; ai < 2; ++ai)
#pragma unroll
                for (int m = 0; m < 4; ++m) { const int row = row0 + ai * 128 + m * 16;
                    f32x4 cs = (f32x4){1.f, 1.f, 1.f, 1.f}, sn = (f32x4){0.f, 0.f, 0.f, 0.f};
                    if (lat) { const int t = row & 2047, pos = half ? (t & 63) : (t >> 6); cs = *(const Gf32x4*)(ropec + pos * 16 + 4 * fq); sn = *(const Gf32x4*)(ropes + pos * 16 + 4 * fq); }
#pragma unroll
                    for (int bj = 0; bj < 2; ++bj) { if (pn == 6 && bj == 1) continue;
                        const f32x4 x1 = acc[ai][bj][m][0], x2 = acc[ai][bj][m][1];
                        const f32x4 o1 = x1 * cs - x2 * sn, o2 = x2 * cs + x1 * sn;
                        GB* p = dst + (size_t)row * ldd + c0 + bj * 128 + cw;
                        st4bf(p, o1); st4bf(p + 16, o2); } }
        } else if (pn < 6 || pn < 14) {
            GB* dst = pn < 6 ? VD : PIN; const int c0 = (pn < 6 ? pn - 4 : pn - 12) * 256;
#pragma unroll
            for (int ai = 0; ai < 2; ++ai)
#pragma unroll
                for (int m = 0; m < 4; ++m) { const int row = row0 + ai * 128 + m * 16;
#pragma unroll
                    for (int bj = 0; bj < 2; ++bj)
#pragma unroll
                        for (int n = 0; n < 2; ++n) st4bf(dst + (size_t)row * 512 + c0 + bj * 128 + cw + 16 * n, acc[ai][bj][m][n]); }
        } else {
            const int c0 = (pn - 14) * 256;
            f32x4 bv[2][2];
#pragma unroll
            for (int bj = 0; bj < 2; ++bj)
#pragma unroll
                for (int n = 0; n < 2; ++n) bv[bj][n] = *(const Gf32x4*)(bgate + c0 + bj * 128 + cw + 16 * n);
#pragma unroll
            for (int ai = 0; ai < 2; ++ai)
#pragma unroll
                for (int m = 0; m < 4; ++m) { const int row = row0 + ai * 128 + m * 16;
#pragma unroll
                    for (int bj = 0; bj < 2; ++bj)
#pragma unroll
                        for (int n = 0; n < 2; ++n) { f32x4 v = acc[ai][bj][m][n] + bv[bj][n];
#pragma unroll
                            for (int j = 0; j < 4; ++j) v[j] = __builtin_amdgcn_rcpf(1.f + __builtin_amdgcn_exp2f(-LOG2E * v[j]));
                            st4bf(GT + (size_t)row * 6144 + c0 + bj * 128 + cw + 16 * n, v); } }
        }
    }
};
struct EpiKV {
    GB*KN, *VM; const GF* SSQKV;
    __device__ __forceinline__ void operator()(AccRef acc, const Unit& u, int wr, int wc, int fr, int fq) const {
        const int row0 = u.pm * 256 + wr * 64 + fr, cw = wc * 32 + 4 * fq;
#pragma unroll
        for (int ai = 0; ai < 2; ++ai)
#pragma unroll
            for (int m = 0; m < 4; ++m) { const int row = row0 + ai * 128 + m * 16;
                const f32x4 s0 = *(const Gf32x4*)(SSQKV + (size_t)row * 8), s1 = *(const Gf32x4*)(SSQKV + (size_t)row * 8 + 4);
                const float ss = ((s0[0] + s0[1]) + (s0[2] + s0[3])) + ((s1[0] + s1[1]) + (s1[2] + s1[3]));
                const float r = 1.f / sqrtf(ss * (1.f / 512.f) + EPS);
#pragma unroll
                for (int n = 0; n < 2; ++n) { st4bf(KN + (size_t)row * 1024 + u.pn * 128 + cw + 16 * n, acc[ai][0][m][n] * r); st4bf(VM + (size_t)row * 1024 + u.pn * 128 + cw + 16 * n, acc[ai][1][m][n] * r); } }
    }
};
struct EpiQ {
    GB* QM; const GF*SSQQ, *ropec, *ropes;
    __device__ __forceinline__ void operator()(AccRef acc, const Unit& u, int wr, int wc, int fr, int fq) const {
        const int row0 = u.pm * 256 + wr * 64 + fr; const bool lat = u.pm < 32;
#pragma unroll
        for (int ai = 0; ai < 2; ++ai)
#pragma unroll
            for (int m = 0; m < 4; ++m) { const int row = row0 + ai * 128 + m * 16;
                const f32x4 s0 = *(const Gf32x4*)(SSQQ + (size_t)row * 12), s1 = *(const Gf32x4*)(SSQQ + (size_t)row * 12 + 4), s2 = *(const Gf32x4*)(SSQQ + (size_t)row * 12 + 8);
                const float ss = ((s0[0] + s0[1]) + (s0[2] + s0[3])) + ((s1[0] + s1[1]) + (s1[2] + s1[3])) + ((s2[0] + s2[1]) + (s2[2] + s2[3]));
                const float r = 1.f / sqrtf(ss * (1.f / 768.f) + EPS);
#pragma unroll
                for (int bj = 0; bj < 2; ++bj) { const int cb = u.pn * 256 + bj * 128 + wc * 32, w0 = cb % 192;
                    f32x4 x1 = acc[ai][bj][m][0] * r, x2 = acc[ai][bj][m][1] * r;
                    if (w0 >= 128 && lat) { const int t = row & 2047, pos = (w0 >= 160) ? (t & 63) : (t >> 6);
                        const f32x4 cs = *(const Gf32x4*)(ropec + pos * 16 + 4 * fq), sn = *(const Gf32x4*)(ropes + pos * 16 + 4 * fq);
                        const f32x4 o1 = x1 * cs - x2 * sn, o2 = x2 * cs + x1 * sn; x1 = o1; x2 = o2; }
                    GB* p = QM + (size_t)row * 1536 + cb + 4 * fq; st4bf(p, x1); st4bf(p + 16, x2); } }
    }
};
struct EpiBf {
    GB* O; int ldc;
    __device__ __forceinline__ void operator()(AccRef acc, const Unit& u, int wr, int wc, int fr, int fq) const {
        const int row0 = u.pm * 256 + wr * 64 + fr, col0 = u.pn * 256 + wc * 32 + 4 * fq;
#pragma unroll
        for (int ai = 0; ai < 2; ++ai)
#pragma unroll
            for (int m = 0; m < 4; ++m) { GB* rp = O + (size_t)(row0 + ai * 128 + m * 16) * ldc + col0;
#pragma unroll
                for (int bj = 0; bj < 2; ++bj)
#pragma unroll
                    for (int n = 0; n < 2; ++n) st4bf(rp + bj * 128 + 16 * n, acc[ai][bj][m][n]); }
    }
};
template <int STEP> struct EpiMerge {
    GB* MG; const GB* GT; GU* flg;
    __device__ __forceinline__ void operator()(AccRef acc, const Unit& u, int wr, int wc, int fr, int fq) const {
        const int row0 = u.pm * 256 + wr * 64 + fr, col0 = u.pn * 256 + wc * 32 + 4 * fq;
        if (STEP > 0 && u.ex > 0) {
            GU* f = flg + (STEP - 1) * 512 + (u.ex - 1); unsigned sp = 0u;
            while (__hip_atomic_load(f, __ATOMIC_RELAXED, __HIP_MEMORY_SCOPE_AGENT) < 8u) { __builtin_amdgcn_s_sleep(2); if (++sp > (1u << 24)) break; }
            __builtin_amdgcn_fence(__ATOMIC_ACQUIRE, "agent");
        }
#pragma unroll
        for (int ai = 0; ai < 2; ++ai)
#pragma unroll
            for (int m = 0; m < 4; ++m) { const int row = row0 + ai * 128 + m * 16;
#pragma unroll
                for (int bj = 0; bj < 2; ++bj)
#pragma unroll
                    for (int n = 0; n < 2; ++n) { const int col = col0 + bj * 128 + 16 * n;
                        const f32x4 gt = ld4bf(GT + (size_t)row * 6144 + STEP * 2048 + col); f32x4 v = gt * acc[ai][bj][m][n];

                        GB* p = MG + (size_t)row * 2048 + col; if (STEP > 0) v = v + ld4bf(p); st4bf(p, v); } }
        if (STEP < 2 && u.ex > 0) {
            __builtin_amdgcn_fence(__ATOMIC_RELEASE, "agent");
            if ((fr | fq) == 0) (void)__hip_atomic_fetch_add(flg + STEP * 512 + (u.ex - 1), 1u, __ATOMIC_RELAXED, __HIP_MEMORY_SCOPE_AGENT);
        }
    }
};
struct EpiWo {
    GB* XS; const GF* modl; const GF* srcL; const GF* srcC; bool f32src;
    __device__ __forceinline__ void operator()(AccRef acc, const Unit& u, int wr, int wc, int fr, int fq) const {
        const int row0 = u.pm * 256 + wr * 64 + fr, col0 = u.pn * 256 + wc * 32 + 4 * fq;
        const int mrow = u.pm < 32 ? (u.pm >> 3) : 4; const GF* g1 = modl + (size_t)mrow * 12288 + 2 * 2048;
        f32x4 gv[2][2];
#pragma unroll
        for (int bj = 0; bj < 2; ++bj)
#pragma unroll
            for (int n = 0; n < 2; ++n) gv[bj][n] = *(const Gf32x4*)(g1 + col0 + bj * 128 + 16 * n);
#pragma unroll
        for (int ai = 0; ai < 2; ++ai)
#pragma unroll
            for (int m = 0; m < 4; ++m) { GB* rp = XS + (size_t)(row0 + ai * 128 + m * 16) * 2048 + col0; const GF* sp = (u.pm < 32 ? srcL : srcC) + (size_t)(row0 + ai * 128 + m * 16) * 2048 + col0;
#pragma unroll
                for (int bj = 0; bj < 2; ++bj)
#pragma unroll
                    for (int n = 0; n < 2; ++n) { GB* p = rp + bj * 128 + 16 * n;
                        const f32x4 res = f32src ? *(const Gf32x4*)(sp + bj * 128 + 16 * n) : ld4h(p);
                        st4h(p, res * DN_ALPHA + gv[bj][n] * acc[ai][bj][m][n]);
                    } }
    }
};
struct EpiGU {
    GB* HB;
    __device__ __forceinline__ void operator()(AccRef acc, const Unit& u, int wr, int wc, int fr, int fq) const {
        const int row0 = u.pm * 256 + wr * 64 + fr, col0 = u.pn * 128 + wc * 32 + 4 * fq;
#pragma unroll
        for (int ai = 0; ai < 2; ++ai)
#pragma unroll
            for (int m = 0; m < 4; ++m) { GB* rp = HB + (size_t)(row0 + ai * 128 + m * 16) * 512 + col0;
#pragma unroll
                for (int n = 0; n < 2; ++n) { const f32x4 gt = acc[ai][0][m][n], up = acc[ai][1][m][n]; f32x4 h;
#pragma unroll
                    for (int j = 0; j < 4; ++j) h[j] = gt[j] * __builtin_amdgcn_rcpf(1.f + __builtin_amdgcn_exp2f(-LOG2E * gt[j])) * up[j];
                    st4bf(rp + 16 * n, h); } }
    }
};


struct RouterP {
    const GB *VH, *VL, *WH, *WL; int K, lda, ldb; static constexpr int kstepB = 128;
    __device__ __forceinline__ const GAS char* aptr(const Unit& u) const { const int part = u.pn >> 1, half = u.pn & 1; return (const GAS char*)((part == 1 ? VL : VH) + (size_t)u.pm * 256 * 2048 + half * 1024); }
    __device__ __forceinline__ const GAS char* bptr(const Unit& u) const { const int part = u.pn >> 1, half = u.pn & 1; return (const GAS char*)((part == 2 ? WL : WH) + half * 1024); }
};
struct SliceOrder { int nM, G, c; __device__ bool next(int i, Unit& u) const { const int L = i * G + c; if (L >= nM * 6) return false; u.pm = L / 6; u.pn = L % 6; u.ex = 0; return true; } };
struct EpiRouter {
    GF* RP;
    __device__ __forceinline__ void operator()(AccRef acc, const Unit& u, int wr, int wc, int fr, int fq) const {
        if (wc >= 3) return;
        const int row0 = u.pm * 256 + wr * 64 + fr;
#pragma unroll
        for (int ai = 0; ai < 2; ++ai)
#pragma unroll
            for (int m = 0; m < 4; ++m) { GF* rp = RP + ((size_t)u.pn * T + row0 + ai * 128 + m * 16) * 80 + wc * 32 + 4 * fq;
#pragma unroll
                for (int n = 0; n < 2; ++n) if (wc * 32 + 16 * n + 4 * fq < 72) *(Gf32x4*)(rp + 16 * n) = acc[ai][0][m][n]; }
    }
};

namespace mg {
constexpr int A_OFF = 0, A_BUF = 49152, B_OFF = 98304, B_BUF = 16384;
__device__ __forceinline__ int swz(int row, int ch) { return row * 128 + ((ch ^ (row & 7)) << 4); }
__device__ __forceinline__ int swzb(int row, int ch) { return row * 128 + ((ch ^ ((((row >> 1) ^ (row >> 4)) & 1) | (((row >> 2) & 3) << 1))) << 4); }
constexpr int TAB_OFF = 135168;
template <int MODE>
__device__ __forceinline__ void moe_gemm(LAS unsigned char* lds, const GB* A, const GF* Wl, GB* O, const GI* ts, const GI* tv, const GI* s2t, int nst, int G, int c) {
    constexpr int K = MODE == 0 ? 2048 : 512, LDW = MODE == 0 ? 1024 : 2048, LDA = K, NPT = MODE == 0 ? 8 : 16, NKT = K / 64;
    int tid_ = threadIdx.x; asm volatile("" : "+v"(tid_));
    const int tid = tid_, wid = __builtin_amdgcn_readfirstlane(tid >> 6), lane = tid & 63, fr = lane & 15, fq = lane >> 4;
    LAS int* tab = (LAS int*)(lds + TAB_OFF);
    if (tid < 128) { const bool in = tid < nst; tab[tid] = in ? __hip_atomic_load(ts + tid, __ATOMIC_RELAXED, __HIP_MEMORY_SCOPE_AGENT) : 0;
        tab[128 + tid] = in ? __hip_atomic_load(tv + tid, __ATOMIC_RELAXED, __HIP_MEMORY_SCOPE_AGENT) : 0; }
    __syncthreads();
    const int tpr = G / NPT;
    int tl, pt;
    if ((G & 7) == 0 && (tpr & 7) == 0) { const int x = c & 7, sl = c >> 3; tl = x * (tpr >> 3) + sl / NPT; pt = sl % NPT; } else { tl = c / NPT; pt = c % NPT; if (tl >= tpr) tl = nst; }
    const int n4 = tid & 31, k4 = tid >> 5;
    const int nb = 4 * n4, bcol = MODE == 0 ? (nb < 64 ? 64 * pt + nb : 512 + 64 * pt + (nb - 64)) : 128 * pt + nb;
    if (tl < nst) {
        int st = tl, e = __builtin_amdgcn_readfirstlane(tab[st]), tvc = __builtin_amdgcn_readfirstlane(tab[128 + st]), ngrp = (tvc + 63) >> 6;
        const GF* W = Wl + (size_t)e * K * LDW; const GB* Ab = A + (size_t)st * 512 * LDA;
        f32x4 acc[3][8];
#pragma unroll
        for (int m = 0; m < 3; ++m)
#pragma unroll
            for (int n = 0; n < 8; ++n) acc[m][n] = (f32x4){0.f, 0.f, 0.f, 0.f};
        f32x4 pb0[4], pb1[4];
#pragma unroll
        for (int q = 0; q < 4; ++q) { pb0[q] = (f32x4){0.f, 0.f, 0.f, 0.f}; pb1[q] = (f32x4){0.f, 0.f, 0.f, 0.f}; }
        unsigned voa = (unsigned)((tid >> 3) * LDA + 8 * ((tid & 7) ^ ((tid >> 3) & 7))) * 2u, vob = (unsigned)(4 * k4 * LDW + bcol) * 4u;
        asm volatile("" : "+v"(voa), "+v"(vob));
        const unsigned ldsw = (unsigned)wid * 1024u;
        const unsigned choff = 16u * (unsigned)((tid & 7) ^ ((tid >> 3) & 7)); unsigned vot = (unsigned)(tid >> 3) * 4u; asm volatile("" : "+v"(vot));
        unsigned voa6[6] = {0u, 0u, 0u, 0u, 0u, 0u}, voa6n[6] = {0u, 0u, 0u, 0u, 0u, 0u};
#define MG_LDT(dst6, stX) do { _Pragma("unroll") for (int i = 0; i < 6; ++i) asm volatile("global_load_dword %0, %1, %2" : "+v"(dst6[i]) : "v"(vot + (unsigned)(i * 256)), "s"((const GAS char*)(s2t + (size_t)(stX) * 512)) : "memory"); } while (0)
#define MG_TOK(dst6, tvX) do { _Pragma("unroll") for (int i = 0; i < 6; ++i) dst6[i] = ((tid >> 3) + 64 * i < (tvX) ? dst6[i] : 0u) * 4096u + choff; } while (0)
#define MG_LDA0(cb, VO, ng_, kt) do { _Pragma("unroll") for (int i = 0; i < 6; ++i) \
            __builtin_amdgcn_global_load_lds((const unsigned*)((const GAS char*)(A + (kt) * 64) + VO[i]), (LAS unsigned*)(lds + A_OFF + (cb) * A_BUF + i * 8192 + ldsw), 16, 0, 0); } while (0)
#define MG_GLD(dst, voff, base) asm volatile("global_load_dwordx4 %0, %1, %2" : "+v"(dst) : "v"(voff), "s"(base) : "memory")
#define MG_LDA(cb, Ab_, ng_, kt) do { _Pragma("unroll") for (int i = 0; i < 6; ++i) \
            __builtin_amdgcn_global_load_lds((const unsigned*)((const GAS char*)((Ab_) + (size_t)(i < (ng_) ? i : 0) * 64 * LDA + (kt) * 64) + voa), (LAS unsigned*)(lds + A_OFF + (cb) * A_BUF + i * 8192 + ldsw), 16, 0, 0); } while (0)
#define MG_LDB(W_, kt, P) do { _Pragma("unroll") for (int q = 0; q < 4; ++q) MG_GLD(P[q], vob, (const GAS char*)((W_) + (size_t)((kt) * 64 + q) * LDW)); } while (0)
#define MG_WAIT(P, N) asm volatile("s_waitcnt vmcnt(" #N ")" : "+v"(P[0]), "+v"(P[1]), "+v"(P[2]), "+v"(P[3]) :: "memory")
#define MG_ITER(cb, P, NW, LOADS) do { \
            MG_WAIT(P, NW); \
            _Pragma("unroll") for (int j = 0; j < 4; ++j) { u32x2 w; w.x = cvt_pk_bf16(P[0][j], P[1][j]); w.y = cvt_pk_bf16(P[2][j], P[3][j]); \
                *(LAS u32x2*)(lds + B_OFF + cb * B_BUF + swzb(nb + j, k4 >> 1) + (k4 & 1) * 8) = w; } \
            asm volatile("s_waitcnt lgkmcnt(0)" ::: "memory"); __builtin_amdgcn_s_barrier();     \
            LOADS;                                                       \
            _Pragma("unroll") for (int ks = 0; ks < 2; ++ks) { \
                bf16x8 Af[3]; \
                _Pragma("unroll") for (int m = 0; m < 3; ++m) Af[m] = *(const LAS bf16x8*)(lds + A_OFF + cb * A_BUF + swz(wid * 48 + m * 16 + fr, ks * 4 + fq)); \
                _Pragma("unroll") for (int nh = 0; nh < 4; ++nh) { \
                    bf16x8 Bf[2]; \
                    _Pragma("unroll") for (int n = 0; n < 2; ++n) Bf[n] = *(const LAS bf16x8*)(lds + B_OFF + cb * B_BUF + swzb((nh * 2 + n) * 16 + fr, ks * 4 + fq)); \
                    _Pragma("unroll") for (int m = 0; m < 3; ++m) \
                        _Pragma("unroll") for (int n = 0; n < 2; ++n) acc[m][nh * 2 + n] = __builtin_amdgcn_mfma_f32_16x16x32_bf16(Bf[n], Af[m], acc[m][nh * 2 + n], 0, 0, 0); \
                } \
            } } while (0)
        if constexpr (MODE == 0) {
            MG_LDT(voa6, st); asm volatile("s_waitcnt vmcnt(0)" : "+v"(voa6[0]), "+v"(voa6[1]), "+v"(voa6[2]), "+v"(voa6[3]), "+v"(voa6[4]), "+v"(voa6[5]) :: "memory"); MG_TOK(voa6, tvc);
            MG_LDB(W, 0, pb0); MG_LDA0(0, voa6, ngrp, 0); MG_LDB(W, 1, pb1);
        } else { MG_LDB(W, 0, pb0); MG_LDA(0, Ab, ngrp, 0); MG_LDB(W, 1, pb1); }
        for (;;) {
            const int stn = st + tpr; const bool more = stn < nst; const int sn = more ? stn : st;
            const int en = __builtin_amdgcn_readfirstlane(tab[sn]), tvn = __builtin_amdgcn_readfirstlane(tab[128 + sn]), ngn = (tvn + 63) >> 6;
            const GF* Wn = Wl + (size_t)en * K * LDW; const GB* Abn = A + (size_t)sn * 512 * LDA;
            if constexpr (MODE == 0) {
                MG_LDT(voa6n, sn);
                { const GF* Wa = W + (size_t)2 * 64 * LDW;
                  MG_ITER(0, pb0, 10, MG_LDA0(1, voa6, ngrp, 1); MG_LDB(Wa, 0, pb0));
                  MG_ITER(1, pb1, 4, MG_LDA0(0, voa6, ngrp, 2); MG_LDB(Wa, 1, pb1)); }
                asm volatile("" : "+v"(voa6n[0]), "+v"(voa6n[1]), "+v"(voa6n[2]), "+v"(voa6n[3]), "+v"(voa6n[4]), "+v"(voa6n[5]));
                MG_TOK(voa6n, tvn);
                for (int kt = 2; kt < NKT - 2; kt += 2) {
                    const GF* Wa = W + (size_t)(kt + 2) * 64 * LDW;
                    MG_ITER(0, pb0, 4, MG_LDA0(1, voa6, ngrp, kt + 1); MG_LDB(Wa, 0, pb0));
                    MG_ITER(1, pb1, 4, MG_LDA0(0, voa6, ngrp, kt + 2); MG_LDB(Wa, 1, pb1));
                }
                MG_ITER(0, pb0, 4, MG_LDA0(1, voa6, ngrp, NKT - 1); MG_LDB(Wn, 0, pb0));
                MG_ITER(1, pb1, 4, MG_LDA0(0, voa6n, ngn, 0); MG_LDB(Wn, 1, pb1));
            } else {
                for (int kt = 0; kt < NKT; kt += 2) {
                    const bool tail = kt + 2 >= NKT;
                    const GF* Wa = tail ? Wn : W + (size_t)(kt + 2) * 64 * LDW; const GB* Aa = tail ? Abn : Ab + (kt + 2) * 64; const int nga = tail ? ngn : ngrp;
                    MG_ITER(0, pb0, 4, MG_LDA(1, Ab, ngrp, kt + 1); MG_LDB(Wa, 0, pb0));
                    MG_ITER(1, pb1, 4, MG_LDA(0, Aa, nga, 0); MG_LDB(Wa, 1, pb1));
                }
            }
            const int row0 = st * 512 + wid * 48 + fr;
            if (MODE == 0) {
#pragma unroll
                for (int m = 0; m < 3; ++m)
#pragma unroll
                    for (int n = 0; n < 4; ++n) { const f32x4 gt = acc[m][n], up = acc[m][n + 4]; f32x4 h;
#pragma unroll
                        for (int j = 0; j < 4; ++j) h[j] = gt[j] * __builtin_amdgcn_rcpf(1.f + __builtin_amdgcn_exp2f(-LOG2E * gt[j])) * up[j];
                        st4bf(O + (size_t)(row0 + m * 16) * 512 + 64 * pt + 16 * n + 4 * fq, h); }
            } else {
#pragma unroll
                for (int m = 0; m < 3; ++m)
#pragma unroll
                    for (int n = 0; n < 8; ++n) st4bf(O + (size_t)(row0 + m * 16) * 2048 + 128 * pt + 16 * n + 4 * fq, acc[m][n]);
            }
            if (!more) break;
#pragma unroll
            for (int m = 0; m < 3; ++m)
#pragma unroll
                for (int n = 0; n < 8; ++n) acc[m][n] = (f32x4){0.f, 0.f, 0.f, 0.f};
            st = stn; W = Wn; Ab = Abn; ngrp = ngn;
#pragma unroll
            for (int i = 0; i < 6; ++i) voa6[i] = voa6n[i];
        }
        asm volatile("s_waitcnt vmcnt(0)" : "+v"(pb0[0]), "+v"(pb0[1]), "+v"(pb0[2]), "+v"(pb0[3]), "+v"(pb1[0]), "+v"(pb1[1]), "+v"(pb1[2]), "+v"(pb1[3]) :: "memory");
#undef MG_ITER
#undef MG_LDA0
#undef MG_TOK
#undef MG_LDT
#undef MG_WAIT
#undef MG_LDB
#undef MG_LDA
#undef MG_GLD
    }
    __syncthreads();
}
}

namespace att {
constexpr int KVBLK = 64;
constexpr int SHM_V = KVBLK * 128 * 2, SHM_K = KVBLK * 128 * 2, SHM_R = KVBLK * 64 * 2;
constexpr int OFF_V = 0, OFF_K = 2 * SHM_V, OFF_R = OFF_K + 2 * SHM_K, OFF_WS = OFF_R + 2 * SHM_R, ATT_LDS = OFF_WS + 8 * 64 * 4;
constexpr float THR2 = 8.f * LOG2E;
#define KSWZ(row, colB) ((row) * 256 + ((colB) ^ (((row) & 7) << 4)))
#define SBAR() __builtin_amdgcn_sched_barrier(0)
__device__ __forceinline__ int crow(int r, int hi) { return (r & 3) + 8 * (r >> 2) + 4 * hi; }
__device__ __forceinline__ void partialSM(f32x16& p0, f32x16& p1, float& m_reg, float& alpha) {
    float pmax = p0[0];
#pragma unroll
    for (int r = 1; r < 16; ++r) pmax = fmaxf(pmax, p0[r]);
#pragma unroll
    for (int r = 0; r < 16; ++r) pmax = fmaxf(pmax, p1[r]);
    { auto rr = __builtin_amdgcn_permlane32_swap(__float_as_uint(pmax), __float_as_uint(pmax), false, false); pmax = fmaxf(__uint_as_float(rr[0]), __uint_as_float(rr[1])); }
    float mn;
    if (__builtin_expect(__all(pmax - m_reg <= THR2), 1)) { mn = m_reg; alpha = 1.f; }
    else { mn = fmaxf(m_reg, pmax); alpha = __builtin_amdgcn_exp2f(m_reg - mn); m_reg = mn; }
#pragma unroll
    for (int r = 0; r < 16; ++r) p0[r] = p0[r] - mn;
#pragma unroll
    for (int r = 0; r < 16; ++r) p1[r] = p1[r] - mn;
#pragma unroll
    for (int r = 0; r < 16; ++r) p0[r] = __builtin_amdgcn_exp2f(p0[r]);
}
__device__ __forceinline__ void finishSM(f32x16& p0, f32x16& p1, float alpha, float& l_reg, bf16x8& pa0, bf16x8& pa1, bf16x8& pa2, bf16x8& pa3) {
#pragma unroll
    for (int r = 0; r < 16; ++r) p1[r] = __builtin_amdgcn_exp2f(p1[r]);
    float ps = 0;
#pragma unroll
    for (int r = 0; r < 16; ++r) ps += p0[r];
#pragma unroll
    for (int r = 0; r < 16; ++r) ps += p1[r];
    { auto rr = __builtin_amdgcn_permlane32_swap(__float_as_uint(ps), __float_as_uint(ps), false, false); ps = __uint_as_float(rr[0]) + __uint_as_float(rr[1]); }
    l_reg = l_reg * alpha + ps;
#define PK4(P, BASE, OUT) do { unsigned a0 = cvt_pk_bf16(P[BASE + 0], P[BASE + 1]), a1 = cvt_pk_bf16(P[BASE + 2], P[BASE + 3]);   \
    unsigned b0 = cvt_pk_bf16(P[BASE + 4], P[BASE + 5]), b1 = cvt_pk_bf16(P[BASE + 6], P[BASE + 7]);                              \
    auto r0 = __builtin_amdgcn_permlane32_swap(a0, b0, false, false); auto r1 = __builtin_amdgcn_permlane32_swap(a1, b1, false, false); \
    u32x4 w = {r0[0], r1[0], r0[1], r1[1]}; OUT = __builtin_bit_cast(bf16x8, w); } while (0)
    PK4(p0, 0, pa0); PK4(p0, 8, pa1); PK4(p1, 0, pa2); PK4(p1, 8, pa3);
#undef PK4
}
__device__ __forceinline__ int v_st(int k, int c) { const int kk = (k & ~0xC) | ((k & 4) << 1) | ((k & 8) >> 1); return ((kk >> 3) * 4 + (c >> 5)) * 512 + ((kk & 7) * 32 + (c & 31)) * 2; }
__device__ __forceinline__ int v_rd_base(int lane) { return ((lane & 3) << 3) | (((lane >> 2) & 3) << 6) | (((lane >> 4) & 1) << 5) | (((lane >> 5) & 1) << 8); }
constexpr int v_rd_off(int d0, int ks, int half) { return d0 * 512 + ks * 4096 + half * 2048; }
template <int OFF> __device__ __forceinline__ s16x4 tr_read(unsigned vb) { s16x4 r; asm volatile("ds_read_b64_tr_b16 %0, %1 offset:%2" : "=&v"(r) : "v"(vb), "i"(OFF) : "memory"); return r; }
template <int D0> __device__ __forceinline__ void pv_one(f32x16& od, unsigned vb, bf16x8 pa0, bf16x8 pa1, bf16x8 pa2, bf16x8 pa3) {
    const s16x4 l0 = tr_read<v_rd_off(D0, 0, 0)>(vb), h0 = tr_read<v_rd_off(D0, 0, 1)>(vb), l1 = tr_read<v_rd_off(D0, 1, 0)>(vb), h1 = tr_read<v_rd_off(D0, 1, 1)>(vb);
    const s16x4 l2 = tr_read<v_rd_off(D0, 2, 0)>(vb), h2 = tr_read<v_rd_off(D0, 2, 1)>(vb), l3 = tr_read<v_rd_off(D0, 3, 0)>(vb), h3 = tr_read<v_rd_off(D0, 3, 1)>(vb);
    asm volatile("s_waitcnt lgkmcnt(0)" ::: "memory"); SBAR();
#define PK(L, H) (bf16x8){L[0], L[1], L[2], L[3], H[0], H[1], H[2], H[3]}
    od = __builtin_amdgcn_mfma_f32_32x32x16_bf16(pa0, PK(l0, h0), od, 0, 0, 0);
    od = __builtin_amdgcn_mfma_f32_32x32x16_bf16(pa1, PK(l1, h1), od, 0, 0, 0);
    od = __builtin_amdgcn_mfma_f32_32x32x16_bf16(pa2, PK(l2, h2), od, 0, 0, 0);
    od = __builtin_amdgcn_mfma_f32_32x32x16_bf16(pa3, PK(l3, h3), od, 0, 0, 0);
#undef PK
}
__device__ __forceinline__ void pv_d0(f32x16* o, unsigned vb, bf16x8 pa0, bf16x8 pa1, bf16x8 pa2, bf16x8 pa3) {
    pv_one<0>(o[0], vb, pa0, pa1, pa2, pa3); pv_one<1>(o[1], vb, pa0, pa1, pa2, pa3); pv_one<2>(o[2], vb, pa0, pa1, pa2, pa3); pv_one<3>(o[3], vb, pa0, pa1, pa2, pa3);
}

struct Args {
    const GB*Q, *K, *V, *KR; GB* O;
    int ldq, ldk, ldo, qcol, kcol, ocol;
    int qrow0;
    int nt_ctx, nt, ctx_row0, lat_row0;
    float lamv, osc; const GF* gsub;
};

template <int MODE>
__device__ __forceinline__ void attn_unit(const Args& a, LAS unsigned char* lds) {
    constexpr int NKS = MODE == 0 ? 12 : 4;
    int tid_ = threadIdx.x; asm volatile("" : "+v"(tid_));
    const int tid = tid_, wid = __builtin_amdgcn_readfirstlane(tid >> 6), lane = tid & 63, r32 = lane & 31, hi = lane >> 5;
    const int grp = MODE == 1 ? (wid >> 2) : 0, wq = MODE == 1 ? (wid & 3) : wid;
    LAS unsigned char* V_lds = lds + OFF_V; LAS unsigned char* K_lds = lds + OFF_K; LAS unsigned char* R_lds = lds + OFF_R;
    LAS float* ws = (LAS float*)(lds + OFF_WS) + wid * 64; LAS float* li_l = ws; LAS float* al_l = ws + 32;
    float m_reg = -1e30f, l_reg = 0; f32x16 o[4] = {}; bf16x8 qr[NKS];
    {
        const GB* Qw = a.Q + (size_t)(a.qrow0 + wq * 32 + r32) * a.ldq + a.qcol + (MODE == 1 ? grp * 64 : 0) + hi * 8;
#pragma unroll
        for (int d0 = 0; d0 < NKS; ++d0) qr[d0] = *(const Gbf16x8*)(Qw + d0 * 16);
    }
    const int sr = tid >> 4, sc = (tid & 15) * 8, vst0 = v_st(sr, sc), vst1 = v_st(32 + sr, sc);
    const int rr = tid >> 3, rc = (tid & 7) * 8, rst = KSWZ(rr & 31, ((rr >> 5) * 64 + rc) * 2);
    const unsigned vb0 = (unsigned)(size_t)V_lds + v_rd_base(lane);
    const GB* Kg = a.K + a.kcol + sc; const GB* Vg = a.V + a.kcol + sc; const GB* Rg = a.KR + rc;
    bf16x8 svs0, svs1, sks0, sks1, skr;
#define KROW(j) ((j) < a.nt_ctx ? a.ctx_row0 + 64 * (j) : a.lat_row0 + 64 * ((j) - a.nt_ctx))
#define SLOAD(j) do { const int k0_ = KROW(j); svs0 = *(const Gbf16x8*)(Vg + (size_t)(k0_ + sr) * a.ldk); svs1 = *(const Gbf16x8*)(Vg + (size_t)(k0_ + 32 + sr) * a.ldk); \
    sks0 = *(const Gbf16x8*)(Kg + (size_t)(k0_ + sr) * a.ldk); sks1 = *(const Gbf16x8*)(Kg + (size_t)(k0_ + 32 + sr) * a.ldk); \
    if (MODE == 0) skr = *(const Gbf16x8*)(Rg + (size_t)(k0_ + rr) * 64); } while (0)
#define SWRITE(b) do { *(LAS bf16x8*)(V_lds + (b) * SHM_V + vst0) = svs0; *(LAS bf16x8*)(V_lds + (b) * SHM_V + vst1) = svs1; const int kc = sc * 2; \
    *(LAS bf16x8*)(K_lds + (b) * SHM_K + KSWZ(sr, kc)) = sks0; *(LAS bf16x8*)(K_lds + (b) * SHM_K + KSWZ(32 + sr, kc)) = sks1; \
    if (MODE == 0) *(LAS bf16x8*)(R_lds + (b) * SHM_R + rst) = skr; } while (0)
#define RESC(al) do { if (__any((al) < 1.f)) { if (hi == 0) al_l[r32] = (al); asm volatile("s_waitcnt lgkmcnt(0)" ::: "memory"); \
    _Pragma("unroll") for (int d = 0; d < 4; ++d) _Pragma("unroll") for (int r = 0; r < 16; ++r) o[d][r] *= al_l[crow(r, hi)]; } } while (0)
#define QKT(P0, P1, b) do { P0 = f32x16{}; P1 = f32x16{}; \
    if (MODE == 0) { \
        _Pragma("unroll") for (int d0 = 0; d0 < 8; ++d0) { const int cb = (d0 * 16 + hi * 8) * 2; \
            const bf16x8 b0 = *(const LAS bf16x8*)(K_lds + (b) * SHM_K + KSWZ(r32, cb)), b1 = *(const LAS bf16x8*)(K_lds + (b) * SHM_K + KSWZ(32 + r32, cb)); \
            P0 = __builtin_amdgcn_mfma_f32_32x32x16_bf16(b0, qr[d0], P0, 0, 0, 0); P1 = __builtin_amdgcn_mfma_f32_32x32x16_bf16(b1, qr[d0], P1, 0, 0, 0); } \
        _Pragma("unroll") for (int d0 = 0; d0 < 4; ++d0) { const int cb = (d0 * 16 + hi * 8) * 2; \
            const bf16x8 b0 = *(const LAS bf16x8*)(R_lds + (b) * SHM_R + KSWZ(r32, cb)), b1 = *(const LAS bf16x8*)(R_lds + (b) * SHM_R + KSWZ(r32, 128 + cb)); \
            P0 = __builtin_amdgcn_mfma_f32_32x32x16_bf16(b0, qr[8 + d0 < NKS ? 8 + d0 : 0], P0, 0, 0, 0); P1 = __builtin_amdgcn_mfma_f32_32x32x16_bf16(b1, qr[8 + d0 < NKS ? 8 + d0 : 0], P1, 0, 0, 0); } \
    } else { \
        _Pragma("unroll") for (int d0 = 0; d0 < 4; ++d0) { const int cb = (grp * 64 + d0 * 16 + hi * 8) * 2; \
            const bf16x8 b0 = *(const LAS bf16x8*)(K_lds + (b) * SHM_K + KSWZ(r32, cb)), b1 = *(const LAS bf16x8*)(K_lds + (b) * SHM_K + KSWZ(32 + r32, cb)); \
            P0 = __builtin_amdgcn_mfma_f32_32x32x16_bf16(b0, qr[d0], P0, 0, 0, 0); P1 = __builtin_amdgcn_mfma_f32_32x32x16_bf16(b1, qr[d0], P1, 0, 0, 0); } \
    } } while (0)
    f32x16 p0, p1; float al; bf16x8 pa0, pa1, pa2, pa3; const int NT = a.nt;
    SLOAD(0); asm volatile("s_waitcnt vmcnt(0)" ::: "memory"); SWRITE(0); __syncthreads();
    for (int j = 0; j < NT; ++j) {
        const int cur = j & 1; const bool more = j + 1 < NT;
        if (more) SLOAD(j + 1);
        SBAR(); QKT(p0, p1, cur);
        partialSM(p0, p1, m_reg, al);
        finishSM(p0, p1, al, l_reg, pa0, pa1, pa2, pa3); SBAR();
        RESC(al);
        pv_d0(o, vb0 + cur * SHM_V, pa0, pa1, pa2, pa3);
        if (more) { asm volatile("s_waitcnt vmcnt(0)" ::: "memory"); SWRITE(cur ^ 1); }
        __syncthreads();
    }
    if (hi == 0) li_l[r32] = l_reg; asm volatile("s_waitcnt lgkmcnt(0)" ::: "memory");
    float rli[16];
#pragma unroll
    for (int r = 0; r < 16; ++r) rli[r] = __builtin_amdgcn_rcpf(li_l[crow(r, hi)]);
    if (MODE == 0) {
        GB* Ow = a.O + (size_t)(a.qrow0 + wq * 32) * a.ldo + a.ocol;
#pragma unroll
        for (int r = 0; r < 16; ++r) { const int orow = crow(r, hi);
#pragma unroll
            for (int d0 = 0; d0 < 4; ++d0) Ow[(size_t)orow * a.ldo + d0 * 32 + r32] = (bf16_t)f2bf(o[d0][r] * rli[r]); }
        __syncthreads();
    } else {
        __syncthreads();
        LAS float* stash = (LAS float*)lds;
        if (grp == 1) {
#pragma unroll
            for (int d0 = 0; d0 < 4; ++d0)
#pragma unroll
                for (int r = 0; r < 16; ++r) stash[((wq * 4 + d0) * 16 + r) * 64 + lane] = o[d0][r] * rli[r];
        }
        __syncthreads();
        if (grp == 0) {
            float ss[16];
#pragma unroll
            for (int r = 0; r < 16; ++r) { ss[r] = 0.f;
#pragma unroll
                for (int d0 = 0; d0 < 4; ++d0) { const float x = o[d0][r] * rli[r] - a.lamv * stash[((wq * 4 + d0) * 16 + r) * 64 + lane]; o[d0][r] = x; ss[r] += x * x; } }
#pragma unroll
            for (int r = 0; r < 16; ++r) {
#pragma unroll
                for (int of = 1; of < 32; of <<= 1) ss[r] += __shfl_xor(ss[r], of);
                ss[r] = a.osc / sqrtf(ss[r] * (1.f / 128.f) + EPS); }
            float gs[4];
#pragma unroll
            for (int d0 = 0; d0 < 4; ++d0) gs[d0] = a.gsub[d0 * 32 + r32];
            GB* Ow = a.O + (size_t)(a.qrow0 + wq * 32) * a.ldo + a.ocol;
#pragma unroll
            for (int r = 0; r < 16; ++r) { const int orow = crow(r, hi);
#pragma unroll
                for (int d0 = 0; d0 < 4; ++d0) Ow[(size_t)orow * a.ldo + d0 * 32 + r32] = (bf16_t)f2bf(o[d0][r] * ss[r] * gs[d0]); }
        }
        __syncthreads();
    }
#undef KROW
#undef SLOAD
#undef SWRITE
#undef RESC
#undef QKT
}
}

#define XB_TMO      128
#define XB_XCNT(j)  (256  + 64 * (j))
#define XB_XSUB(j)  (1280 + 64 * (j))
#define XB_XGEN(j)  (2304 + 64 * (j))
#define XB_TOP      3328
#define XB_TOPGEN   3392
#define XCD_BAR_WORDS 3456
#define XB_SPIN_CAP (1u << 22)
__device__ __forceinline__ unsigned xb_ld(unsigned* p)              { return __hip_atomic_load(p, __ATOMIC_RELAXED, __HIP_MEMORY_SCOPE_AGENT); }
__device__ __forceinline__ unsigned xb_add(unsigned* p, unsigned v) { return __hip_atomic_fetch_add(p, v, __ATOMIC_RELAXED, __HIP_MEMORY_SCOPE_AGENT); }
__device__ __forceinline__ unsigned xb_xcc_id() { return (unsigned)__builtin_amdgcn_s_getreg((3 << 11) | 20) & 0xFu; }
#define XB_SPIN(cond, bar) do { unsigned _sp = 0; while (cond) { __builtin_amdgcn_s_sleep(1); \
    if ((++_sp & 255u) == 0u) { if (xb_ld(&(bar)[XB_TMO])) break; if (_sp > XB_SPIN_CAP) { atomicAdd(&(bar)[XB_TMO], 1u); break; } } } } while (0)
struct XcdBarrier { unsigned* bar; unsigned x; volatile LAS unsigned* st; };
__device__ __forceinline__ XcdBarrier xcd_barrier_post(unsigned* bar, volatile LAS unsigned* st) {
    XcdBarrier b; b.bar = bar; b.x = xb_xcc_id(); b.st = st;
    if (threadIdx.x == 0) (void)xb_add(&bar[XB_XCNT(b.x)], 1u);
    return b;
}
__device__ __forceinline__ void xcd_barrier_complete(unsigned* bar, unsigned x, unsigned& nloc, unsigned& nx) {
    const unsigned G = gridDim.x * gridDim.y * gridDim.z;
    unsigned sum, cnt, mine, sp = 0u;
    for (;;) {
        sum = 0u; cnt = 0u; mine = 0u;
#pragma unroll
        for (unsigned j = 0; j < 16; ++j) { const unsigned c = xb_ld(&bar[XB_XCNT(j)]); sum += c; cnt += (c > 0u) ? 1u : 0u; mine = (j == x) ? c : mine; }
        if (sum == G) break;
        __builtin_amdgcn_s_sleep(1);
        if ((++sp & 255u) == 0u) { if (xb_ld(&bar[XB_TMO])) break; if (sp > XB_SPIN_CAP) { atomicAdd(&bar[XB_TMO], 1u); break; } }
    }
    nloc = mine > 0u ? mine : 1u; nx = cnt > 0u ? cnt : 1u;
}
__device__ __forceinline__ void xcd_barrier(const XcdBarrier& b) {
    asm volatile("s_waitcnt vmcnt(0)" ::: "memory");
    __syncthreads();
    if (threadIdx.x == 0) {
        unsigned* bar = b.bar;
        __builtin_amdgcn_s_waitcnt(0);
        unsigned nloc = b.st[0], nx = b.st[1];
        if (nloc == 0u) { xcd_barrier_complete(bar, b.x, nloc, nx); b.st[0] = nloc; b.st[1] = nx; }
        const unsigned old = xb_add(&bar[XB_XSUB(b.x)], 1u);
        const unsigned gen = old / nloc;
        if (old + 1u == (gen + 1u) * nloc) {
            __builtin_amdgcn_fence(__ATOMIC_RELEASE, "agent");
            asm volatile("s_waitcnt vmcnt(0)" ::: "memory");
            const unsigned og = xb_add(&bar[XB_TOP], 1u);
            const unsigned tg = og / nx;
            if (og + 1u == (tg + 1u) * nx) xb_add(&bar[XB_TOPGEN], 1u);
            else XB_SPIN(xb_ld(&bar[XB_TOPGEN]) == tg, bar);
            __builtin_amdgcn_fence(__ATOMIC_ACQUIRE, "agent");
            xb_add(&bar[XB_XGEN(b.x)], 1u);
            asm volatile("s_waitcnt vmcnt(0)" ::: "memory");
        } else {
            XB_SPIN(xb_ld(&bar[XB_XGEN(b.x)]) == gen, bar);
            __builtin_amdgcn_fence(__ATOMIC_ACQUIRE, "agent");
            asm volatile("s_waitcnt vmcnt(0)" ::: "memory");
        }
    }
    __syncthreads();
}

constexpr int NWAVES = 8;
constexpr int RING_BYTES = 131072, LDSCTL_OFF = RING_BYTES, MISC_OFF = LDSCTL_OFF + 320, LDS_BYTES = 147456;
constexpr int NPHASE = 2 + 10 * NL;

struct Args {
    const float* in[30]; float* out; unsigned char* ws; int ph_lo, ph_hi, region, pad;
};

__device__ __forceinline__ void cvt_item(const GF* W, int ldw, int k0, int n0, GB* dst, int drow0, int ldd, const GF* sk, const GF* sn, float s, LAS float* scr, int lane) {
#pragma unroll 8
    for (int i = 0; i < 32; ++i) { const int kk = 2 * i + (lane >> 5); scr[kk * 33 + (lane & 31)] = W[(size_t)(k0 + kk) * ldw + n0 + (lane & 31)]; }
    asm volatile("s_waitcnt lgkmcnt(0)" ::: "memory");
    const int c = lane & 7;
    float skv[8];
#pragma unroll
    for (int q = 0; q < 8; ++q) skv[q] = sk ? sk[k0 + 8 * c + q] * s : s;
#pragma unroll
    for (int j = 0; j < 4; ++j) { const int n = (lane >> 3) + 8 * j; const LAS float* sp = scr + (8 * c) * 33 + n; const float f = sn ? sn[n0 + n] : 1.f;
        u32x4 o; o.x = pk2(sp[0 * 33] * skv[0] * f, sp[1 * 33] * skv[1] * f); o.y = pk2(sp[2 * 33] * skv[2] * f, sp[3 * 33] * skv[3] * f);
        o.z = pk2(sp[4 * 33] * skv[4] * f, sp[5 * 33] * skv[5] * f); o.w = pk2(sp[6 * 33] * skv[6] * f, sp[7 * 33] * skv[7] * f);
        *(Gu32x4*)(dst + (size_t)(drow0 + n) * ldd + k0 + 8 * c) = o; }
    asm volatile("s_waitcnt lgkmcnt(0)" ::: "memory");
}
__device__ __forceinline__ int win_dest_row(int n) {
    if (n < 512) return n;
    if (n < 576) return 1536 + (n - 512);
    if (n < 1088) return 512 + (n - 576);
    if (n < 1600) return 1024 + (n - 1088);
    if (n < 2368) return 1792 + (n - 1600);
    if (n < 2880) return 2560 + (n - 2368);
    if (n < 3392) return 3072 + (n - 2880);
    return 3584 + (n - 3392);
}

__global__ void __launch_bounds__(NWAVES * 64, 2) fwd(Args args) {
    extern __shared__ __attribute__((aligned(16))) unsigned char lds_raw[];
    LAS unsigned char* lds = (LAS unsigned char*)lds_raw;
    volatile LAS unsigned* MISC = (volatile LAS unsigned*)(lds + MISC_OFF);
    const int G = gridDim.x, bid = blockIdx.x, NGW = G * NWAVES;
#define PHASE_IDS() int tid_ = threadIdx.x; asm volatile("" : "+v"(tid_)); const int tid = tid_, lane = tid & 63, wave = __builtin_amdgcn_readfirstlane(tid >> 6), gw = bid * NWAVES + wave; (void)lane; (void)gw
    unsigned* ctl0 = (unsigned*)(args.ws + WS_CTL);
    for (int u = threadIdx.x; u < (LDS_BYTES - LDSCTL_OFF) / 4; u += NWAVES * 64) ((LAS unsigned*)(lds + LDSCTL_OFF))[u] = 0u;
    __syncthreads();
    XcdBarrier bar; bar.bar = ctl0 + CW_BAR + args.region * XCD_BAR_WORDS; bar.x = 0; bar.st = nullptr;
    const int lo = args.ph_lo, hi = args.ph_hi;
    const bool multi = (hi - lo) > 1;
    if (multi) bar = xcd_barrier_post(ctl0 + CW_BAR + args.region * XCD_BAR_WORDS, MISC + 8);
#ifdef ONLY
#define IN(k) ((((k) < 2 ? 100 + (k) : ((k) - 2) % 10) == ONLY) && lo <= (k) && (k) < hi)
#elif defined(EXCL)
#define IN(k) ((((k) < 2 ? 100 + (k) : ((k) - 2) % 10) != EXCL) && lo <= (k) && (k) < hi)
#else
#define IN(k) (lo <= (k) && (k) < hi)
#endif
#define SEAM(k) do { if (IN((k) + 1)) xcd_barrier(bar); } while (0)
#define SEAM_MID() do { if (multi) xcd_barrier(bar); } while (0)

#define PHASE_PTRS() CKA* kp = (CKA*)__builtin_amdgcn_kernarg_segment_ptr(); asm volatile("" : "+s"(kp)); GC* ws = (GC*)*(const unsigned long long __attribute__((address_space(4)))*)(kp + 248); GU* ctl = (GU*)(ws + WS_CTL); (void)ctl
#define INP(i) ((const GF*)*(const unsigned long long __attribute__((address_space(4)))*)(kp + 8 * (i)))
#define WSP(T, off) ((GAS T*)(ws + (off)))
    enum { I_X = 0, I_C, I_CTX, I_CCTX, I_WADA, I_BADA, I_WIN, I_BGATE, I_GQ, I_GKV, I_WUQ, I_WUKV, I_LAM, I_GSUB, I_WPOOL, I_PSCALE, I_WBM, I_WBD, I_WBP, I_WO, I_LN1G, I_LN1B, I_WGRP, I_BGRP, I_WEXP, I_BEXP, I_WGU, I_WDN, I_LN2G, I_LN2B };
    if (IN(0)) {
        PHASE_PTRS(); PHASE_IDS();
        const GF* c_in = INP(I_C); const GF* cctx_in = INP(I_CCTX); const GF* w_ada = INP(I_WADA); const GF* b_ada = INP(I_BADA);
        GF* MOD = WSP(float, WS_MOD); GF* ROPEC = WSP(float, WS_ROPE); GF* ROPES = ROPEC + 1024;
        {
            LAS float* sl = (LAS float*)lds;
            LAS float* red = sl + 5 * 2048;
            for (int i = tid; i < 5 * 2048; i += 512) { const float v = i < 4 * 2048 ? c_in[i] : cctx_in[i - 4 * 2048]; sl[i] = v / (1.f + __expf(-v)); }
            __syncthreads();
            const int c4 = tid & 7, kg = tid >> 3;
            for (int unit = bid; unit < NL * 384; unit += G) {
                const int l = unit / 384, c0 = (unit % 384) * 32;
                const GF* wp = w_ada + ((size_t)l * 2048 + kg) * 12288 + c0 + 4 * c4;
                f32x4 a0 = {0.f, 0.f, 0.f, 0.f}, a1 = a0, a2 = a0, a3 = a0, a4 = a0;
#pragma unroll 8
                for (int it = 0; it < 32; ++it) { const int k = kg + 64 * it; const f32x4 w = *(const Gf32x4*)(wp + (size_t)64 * it * 12288);
                    a0 += w * sl[k]; a1 += w * sl[2048 + k]; a2 += w * sl[4096 + k]; a3 += w * sl[6144 + k]; a4 += w * sl[8192 + k]; }
                *(LAS f32x4*)(red + (kg * 5 + 0) * 32 + 4 * c4) = a0; *(LAS f32x4*)(red + (kg * 5 + 1) * 32 + 4 * c4) = a1; *(LAS f32x4*)(red + (kg * 5 + 2) * 32 + 4 * c4) = a2;
                *(LAS f32x4*)(red + (kg * 5 + 3) * 32 + 4 * c4) = a3; *(LAS f32x4*)(red + (kg * 5 + 4) * 32 + 4 * c4) = a4;
                __syncthreads();
                if (tid < 160) { const int r = tid >> 5, col = tid & 31; float s = 0.f;
                    for (int q = 0; q < 64; ++q) s += red[(q * 5 + r) * 32 + col];
                    MOD[((size_t)l * 5 + r) * 12288 + c0 + col] = s + b_ada[(size_t)l * 12288 + c0 + col]; }
                __syncthreads();
            }
        }
        if (bid == 0 && tid < NL * 64) ctl[CW_CNT + tid] = 0u;
        if (bid == 0) for (int i = tid; i < 1024; i += 512) { const int pos = i >> 4, f = i & 15; const float inv = powf(10000.f, -(float)f / 16.f); const float ang = (float)pos * inv; ROPEC[i] = cosf(ang); ROPES[i] = sinf(ang); }
        for (int i = bid * 512 + tid; i < NL * 256 * 2048; i += G * 512) { const int l = i / (256 * 2048), r = i % (256 * 2048), cc = r / 2048, k = r % 2048;
            const float w = cc < 8 ? INP(I_WGRP)[((size_t)l * 2048 + k) * 8 + cc] : (cc < 72 ? INP(I_WEXP)[((size_t)l * 2048 + k) * 64 + (cc - 8)] : 0.f);
            const unsigned hi = f2bf(w); const float rem = w - __builtin_bit_cast(float, hi << 16);
            GB* wr = WSP(bf16_t, WS_WRT) + (size_t)l * 2 * 256 * 2048; wr[r] = (bf16_t)hi; wr[256 * 2048 + r] = (bf16_t)f2bf(rem); }
        for (int i = bid * 512 + tid; i < NL * 192 * 256; i += G * 512) { const int l = i / (192 * 256), r = i % (192 * 256); *(Gu32x4*)(WSP(bf16_t, WS_WIN) + ((size_t)l * NP + 1600) * 2048 + (size_t)r * 8) = (u32x4){0u, 0u, 0u, 0u}; }
        {
            LAS float* scr = (LAS float*)(lds + wave * 16384);
            constexpr int I_IN = 32 * 298, I_UKV = 8 * 64, I_UQ = 12 * 48, I_PL = 8 * 16, I_BM = 16 * 64, I_BD = 8 * 64, I_BP = 8 * 64, I_O = 32 * 64, I_GU = 0, I_DN = 0;
            constexpr int I_LAYER = I_IN + I_UKV + I_UQ + I_PL + I_BM + I_BD + I_BP + I_O + I_GU + I_DN;
            for (int it = gw; it < NL * I_LAYER; it += NGW) {
                const int l = it / I_LAYER; int r = it % I_LAYER;
                if (r < I_IN) { const int kb = r / 298, nb = r % 298, n0 = nb * 32; const float s = (n0 >= 2368 && n0 < 2880) ? 0.125f * LOG2E : 1.f;
                    cvt_item(INP(I_WIN) + (size_t)l * 2048 * IN_COLS, IN_COLS, kb * 64, n0, WSP(bf16_t, WS_WIN) + (size_t)l * NP * 2048, win_dest_row(n0) - 0, 2048, nullptr, nullptr, s, scr, lane); continue; } r -= I_IN;
                if (r < I_UKV) { const int kb = r / 64, nb = r % 64; cvt_item(INP(I_WUKV) + (size_t)l * 512 * 2048, 2048, kb * 64, nb * 32, WSP(bf16_t, WS_WUKV) + (size_t)l * 2048 * 512, nb * 32, 512, INP(I_GKV) + l * 512, nullptr, 1.f, scr, lane); continue; } r -= I_UKV;
                if (r < I_UQ) { const int kb = r / 48, nb = r % 48; cvt_item(INP(I_WUQ) + (size_t)l * 768 * 1536, 1536, kb * 64, nb * 32, WSP(bf16_t, WS_WUQ) + (size_t)l * 1536 * 768, nb * 32, 768, INP(I_GQ) + l * 768, nullptr, 0.07216878364870322f * LOG2E, scr, lane); continue; } r -= I_UQ;
                if (r < I_PL) { const int kb = r / 16, nb = r % 16, gk = kb >> 1, gn = nb >> 2;
                    if (gk == gn) cvt_item(INP(I_WPOOL) + ((size_t)l * 4 + gk) * 128 * 128, 128, (kb & 1) * 64, (nb & 3) * 32, WSP(bf16_t, WS_WPL) + (size_t)l * 512 * 512 + gk * 128, nb * 32, 512, nullptr, INP(I_PSCALE) + l * 512 + gn * 128, 1.f, scr, lane);
                    else { GB* dp = WSP(bf16_t, WS_WPL) + (size_t)l * 512 * 512 + (size_t)(nb * 32 + (lane >> 1)) * 512 + kb * 64 + (lane & 1) * 32;
#pragma unroll
                        for (int q = 0; q < 4; ++q) *(Gu32x4*)(dp + q * 8) = (u32x4){0u, 0u, 0u, 0u}; }
                    continue; } r -= I_PL;
                if (r < I_BM) { const int kb = r / 64, nb = r % 64; cvt_item(INP(I_WBM) + (size_t)l * 1024 * 2048, 2048, kb * 64, nb * 32, WSP(bf16_t, WS_WBM) + (size_t)l * 2048 * 1024, nb * 32, 1024, nullptr, nullptr, 1.f, scr, lane); continue; } r -= I_BM;
                if (r < I_BD) { const int kb = r / 64, nb = r % 64; cvt_item(INP(I_WBD) + (size_t)l * 512 * 2048, 2048, kb * 64, nb * 32, WSP(bf16_t, WS_WBD) + (size_t)l * 2048 * 512, nb * 32, 512, nullptr, nullptr, 1.f, scr, lane); continue; } r -= I_BD;
                if (r < I_BP) { const int kb = r / 64, nb = r % 64; cvt_item(INP(I_WBP) + (size_t)l * 512 * 2048, 2048, kb * 64, nb * 32, WSP(bf16_t, WS_WBP) + (size_t)l * 2048 * 512, nb * 32, 512, nullptr, nullptr, 1.f, scr, lane); continue; } r -= I_BP;
                if (r < I_O) { const int kb = r / 64, nb = r % 64; cvt_item(INP(I_WO) + (size_t)l * 2048 * 2048, 2048, kb * 64, nb * 32, WSP(bf16_t, WS_WO) + (size_t)l * 2048 * 2048, nb * 32, 2048, nullptr, nullptr, 1.f, scr, lane); continue; } r -= I_O;
            }
        }
        SEAM(0);
    }
    if (IN(1)) {
        PHASE_PTRS(); PHASE_IDS();
        const GF* x_in = INP(I_X); const GF* ctx_in = INP(I_CTX); const GF* MOD = WSP(float, WS_MOD); GB* U = WSP(bf16_t, WS_U);
        for (int pr = gw; pr < T / 2; pr += NGW) {
            const int row = 2 * pr;
            const GF* src = row < TL ? x_in + (size_t)row * 2048 : ctx_in + (size_t)(row - TL) * 2048; const int mrow = row < TL ? (row >> 11) : 4;
            const GF* md = MOD + (size_t)mrow * 12288;
            f32x4 v[2][8]; float sm[2] = {0.f, 0.f};
#pragma unroll
            for (int r = 0; r < 2; ++r)
#pragma unroll
                for (int j = 0; j < 8; ++j) v[r][j] = *(const Gf32x4*)(src + r * 2048 + 4 * lane + 256 * j);
#pragma unroll
            for (int r = 0; r < 2; ++r)
#pragma unroll
                for (int j = 0; j < 8; ++j) { sm[r] += (v[r][j][0] + v[r][j][1]) + (v[r][j][2] + v[r][j][3]); }
            float rstd[2];
#pragma unroll
            for (int r = 0; r < 2; ++r) { const float mean = wave_sum(sm[r]) * (1.f / 2048.f); float s2 = 0.f;
#pragma unroll
                for (int j = 0; j < 8; ++j) { v[r][j] = v[r][j] - mean; s2 += (v[r][j][0] * v[r][j][0] + v[r][j][1] * v[r][j][1]) + (v[r][j][2] * v[r][j][2] + v[r][j][3] * v[r][j][3]); }
                rstd[r] = 1.f / sqrtf(wave_sum(s2) * (1.f / 2048.f) + EPS); }
#pragma unroll
            for (int j = 0; j < 8; ++j) { const int c = 4 * lane + 256 * j; const f32x4 sh = *(const Gf32x4*)(md + c), scv = *(const Gf32x4*)(md + 2048 + c) + 1.f;
#pragma unroll
                for (int r = 0; r < 2; ++r) st4bf(U + (size_t)(row + r) * 2048 + c, v[r][j] * rstd[r] * scv + sh); }
        }
        SEAM(1);
    }

    for (int l = 0; l < NL; ++l) {
        const int pb = 2 + 10 * l; const bool last = (l == NL - 1);
        const int nMall = last ? 32 : 36;
        const float lam_init = 0.8f - 0.6f * __expf(-0.3f * (float)l);
        if (IN(pb + 0)) {
            PHASE_PTRS(); PHASE_IDS();
            pg8::Plain g{WSP(bf16_t, WS_U), WSP(bf16_t, WS_WIN) + (size_t)l * NP * 2048, 2048, 2048, 2048};
            pg8::RectOrder S; if (last) S.init(32, 38, G, bid, 32, 4, 7); else S.init(36, 38, G, bid);
            EpiIn E{ws, INP(I_BGATE) + (size_t)l * 6144};
            pg8::gemm_phase<pg8::Plain, EpiIn, pg8::RectOrder>(lds, g, S, E);
            SEAM(pb + 0);
        }
        if (IN(pb + 1)) {
            PHASE_PTRS(); PHASE_IDS();
            const GB* PIN = WSP(bf16_t, WS_PIN); GB* PL = WSP(bf16_t, WS_PL);
            {
                const int nrows = nMall * 256;
                for (int i = bid * 512 + tid; i < nrows * 64; i += G * 512) {
                    const int row = i >> 6, c8 = (i & 63) * 8, gi = c8 >> 7, half = 1 << gi;
                    int t, s, base; if (row < TL) { t = row & 2047; s = 2048; base = row - t; } else { t = (row - TL) & 255; s = 256; base = row - t; }
                    const int lo_ = t - half < 0 ? 0 : t - half, hi_ = t + half > s ? s : t + half;
                    float a[8] = {0.f, 0.f, 0.f, 0.f, 0.f, 0.f, 0.f, 0.f};
                    for (int q = lo_; q < hi_; ++q) { const u32x4 w = *(const Gu32x4*)(PIN + (size_t)(base + q) * 512 + c8);
                        a[0] += bflo(w.x); a[1] += bfhi(w.x); a[2] += bflo(w.y); a[3] += bfhi(w.y); a[4] += bflo(w.z); a[5] += bfhi(w.z); a[6] += bflo(w.w); a[7] += bfhi(w.w); }
                    const float inv = 1.f / (float)(hi_ - lo_); const u32x4 w = *(const Gu32x4*)(PIN + (size_t)row * 512 + c8);
                    u32x4 o; o.x = pk2(a[0] * inv - bflo(w.x), a[1] * inv - bfhi(w.x)); o.y = pk2(a[2] * inv - bflo(w.y), a[3] * inv - bfhi(w.y));
                    o.z = pk2(a[4] * inv - bflo(w.z), a[5] * inv - bfhi(w.z)); o.w = pk2(a[6] * inv - bflo(w.w), a[7] * inv - bfhi(w.w));
                    *(Gu32x4*)(PL + (size_t)row * 512 + c8) = o;
                }
            }
            { pg8::Plain g{WSP(bf16_t, WS_CKV), WSP(bf16_t, WS_WUKV) + (size_t)l * 2048 * 512, 512, 512, 512}; pg8::RectOrder S; S.init(36, 8, G, bid);
              EpiKV E{WSP(bf16_t, WS_KN), WSP(bf16_t, WS_VM), WSP(float, WS_SSQKV)}; pg8::gemm_phase<pg8::Plain, EpiKV, pg8::RectOrder>(lds, g, S, E); }
            { pg8::Plain g{WSP(bf16_t, WS_CQ), WSP(bf16_t, WS_WUQ) + (size_t)l * 1536 * 768, 768, 768, 768}; pg8::RectOrder S; S.init(nMall, 6, G, bid); if ((G & 7) == 0 && G > nMall * 6) S.rot0 = (G - nMall * 6) & ~7;
              EpiQ E{WSP(bf16_t, WS_QM), WSP(float, WS_SSQQ), WSP(float, WS_ROPE), WSP(float, WS_ROPE) + 1024}; pg8::gemm_phase<pg8::Plain, EpiQ, pg8::RectOrder>(lds, g, S, E); }
            SEAM(pb + 1);
        }
        if (IN(pb + 2)) {
            PHASE_PTRS(); PHASE_IDS();
#ifndef NO_POOLG
            { pg8::Plain g{WSP(bf16_t, WS_PL), WSP(bf16_t, WS_WPL) + (size_t)l * 512 * 512, 512, 512, 512}; pg8::RectOrder S; S.init(nMall, 2, G, bid); if ((G & 7) == 0 && G > nMall * 2) S.rot0 = (G - nMall * 2) & ~7;
              EpiBf E{WSP(bf16_t, WS_OP), 512}; pg8::gemm_phase<pg8::Plain, EpiBf, pg8::RectOrder>(lds, g, S, E); }
#endif
            float lamv;
            { const GF* lp = INP(I_LAM) + (size_t)l * 256; const float sa = wave_sum(lp[lane] * lp[64 + lane]), sb = wave_sum(lp[128 + lane] * lp[192 + lane]); lamv = (expf(sa) - expf(sb)) + lam_init; }
#ifndef NO_MLA
            for (int un = bid; un < (last ? 256 : 288); un += G) {
                att::Args a; a.lamv = 0.f; a.osc = 0.f; a.gsub = INP(I_GSUB); a.KR = WSP(bf16_t, WS_KR); int b, h;
                if (un < 256) { b = un >> 6; h = (un >> 3) & 7; a.qrow0 = b * 2048 + (un & 7) * 256; a.nt = 36; }
                else { const int v = un - 256; b = v >> 3; h = v & 7; a.qrow0 = TL + b * 256; a.nt = 4; }
                a.nt_ctx = 4; a.ctx_row0 = TL + b * 256; a.lat_row0 = b * 2048;
                a.Q = WSP(bf16_t, WS_QM); a.ldq = 1536; a.qcol = h * 192; a.K = WSP(bf16_t, WS_KN); a.V = WSP(bf16_t, WS_VM); a.ldk = 1024; a.kcol = h * 128; a.O = WSP(bf16_t, WS_OM); a.ldo = 1024; a.ocol = h * 128;
                att::attn_unit<0>(a, lds);
            }
#endif
#ifndef NO_DIFF
            for (int un0 = bid; un0 < (last ? 256 : (G == 256 ? 320 : 288)); un0 += G) {
                int un = un0; if (G == 256 && un0 >= 256) { if (un0 < 288) continue; un = un0 - 32; }
                att::Args a; a.lamv = lamv; a.osc = 1.f - lam_init; a.gsub = INP(I_GSUB) + (size_t)l * 128; a.KR = WSP(bf16_t, WS_KR); int b, h;
                if (un < 256) { b = un >> 6; h = (un >> 4) & 3; a.qrow0 = b * 2048 + (un & 15) * 128; a.nt = 36; }
                else { const int v = un - 256; b = v >> 3; h = (v >> 1) & 3; a.qrow0 = TL + b * 256 + (v & 1) * 128; a.nt = 4; }
                a.nt_ctx = 4; a.ctx_row0 = TL + b * 256; a.lat_row0 = b * 2048;
                a.Q = WSP(bf16_t, WS_QD); a.ldq = 512; a.qcol = h * 128; a.K = WSP(bf16_t, WS_KD); a.V = WSP(bf16_t, WS_VD); a.ldk = 512; a.kcol = h * 128; a.O = WSP(bf16_t, WS_OD); a.ldo = 512; a.ocol = h * 128;
                att::attn_unit<1>(a, lds);
            }
#endif
            SEAM(pb + 2);
        }
        if (IN(pb + 3)) {
            PHASE_PTRS(); PHASE_IDS();
            GB* MG = WSP(bf16_t, WS_MG); const GB* GT = WSP(bf16_t, WS_GT);
            pg8::RectOrder S; S.init(nMall, 8, G, bid); GU* flg = ctl + CW_FLG + l * 2048;
            const int rstep = (G >= 192 && (G & 7) == 0) ? 64 : 0;
            { pg8::Plain g{WSP(bf16_t, WS_OM), WSP(bf16_t, WS_WBM) + (size_t)l * 2048 * 1024, 1024, 1024, 1024}; EpiMerge<0> E{MG, GT, flg}; pg8::gemm_phase<pg8::Plain, EpiMerge<0>, pg8::RectOrder>(lds, g, S, E); }
            S.rot = rstep;
            { pg8::Plain g{WSP(bf16_t, WS_OD), WSP(bf16_t, WS_WBD) + (size_t)l * 2048 * 512, 512, 512, 512}; EpiMerge<1> E{MG, GT, flg}; pg8::gemm_phase<pg8::Plain, EpiMerge<1>, pg8::RectOrder>(lds, g, S, E); }
            S.rot = 2 * rstep;
            { pg8::Plain g{WSP(bf16_t, WS_OP), WSP(bf16_t, WS_WBP) + (size_t)l * 2048 * 512, 512, 512, 512}; EpiMerge<2> E{MG, GT, flg}; pg8::gemm_phase<pg8::Plain, EpiMerge<2>, pg8::RectOrder>(lds, g, S, E); }
            SEAM(pb + 3);
        }
        if (IN(pb + 4)) {
            PHASE_PTRS(); PHASE_IDS();
            pg8::Plain g{WSP(bf16_t, WS_MG), WSP(bf16_t, WS_WO) + (size_t)l * 2048 * 2048, 2048, 2048, 2048}; pg8::RectOrder S; S.init(nMall, 8, G, bid);
            EpiWo E{WSP(bf16_t, WS_XS), WSP(float, WS_MOD) + (size_t)l * 5 * 12288, INP(I_X), INP(I_CTX) - (size_t)TL * 2048, l == 0}; pg8::gemm_phase<pg8::Plain, EpiWo, pg8::RectOrder>(lds, g, S, E);
            SEAM(pb + 4);
        }
        if (IN(pb + 5)) {
            PHASE_PTRS(); PHASE_IDS();
            const GF* modl = WSP(float, WS_MOD) + (size_t)l * 5 * 12288; const GB* XS = WSP(bf16_t, WS_XS); GB* VB = WSP(bf16_t, WS_VB); GI* TOPK = WSP(int, WS_TOPK);
            const GF* ln1_g = INP(I_LN1G); const GF* ln1_b = INP(I_LN1B); const GF* b_grp = INP(I_BGRP); const GF* b_exp = INP(I_BEXP);
            const int nrows = nMall * 256; GB* VLO = WSP(bf16_t, WS_VLO);
            for (int pr = gw; pr < nrows / 2; pr += NGW) {
                const int row = 2 * pr; const int mrow = row < TL ? (row >> 11) : 4; const GF* md = modl + (size_t)mrow * 12288;
                f32x4 v[2][8]; float sm[2] = {0.f, 0.f}, rstd[2];
#pragma unroll
                for (int r = 0; r < 2; ++r)
#pragma unroll
                    for (int j = 0; j < 8; ++j) v[r][j] = ld4h(XS + (size_t)(row + r) * 2048 + 4 * lane + 256 * j);
#pragma unroll
                for (int r = 0; r < 2; ++r) {
#pragma unroll
                    for (int j = 0; j < 8; ++j) sm[r] += (v[r][j][0] + v[r][j][1]) + (v[r][j][2] + v[r][j][3]);
                    const float mean = wave_sum(sm[r]) * (1.f / 2048.f); float s2 = 0.f;
#pragma unroll
                    for (int j = 0; j < 8; ++j) { v[r][j] = v[r][j] - mean; s2 += (v[r][j][0] * v[r][j][0] + v[r][j][1] * v[r][j][1]) + (v[r][j][2] * v[r][j][2] + v[r][j][3] * v[r][j][3]); }
                    rstd[r] = 1.f / sqrtf(wave_sum(s2) * (1.f / 2048.f) + EPS); sm[r] = 0.f;
                    if (lane == 0) { GF* stp = WSP(float, WS_SSQKV) + (size_t)(row + r) * 8; stp[0] = mean; stp[1] = rstd[r]; } }
#pragma unroll
                for (int j = 0; j < 8; ++j) { const int c = 4 * lane + 256 * j; const f32x4 gg = *(const Gf32x4*)(ln1_g + l * 2048 + c), bb = *(const Gf32x4*)(ln1_b + l * 2048 + c);
#pragma unroll
                    for (int r = 0; r < 2; ++r) { v[r][j] = v[r][j] * rstd[r] * gg + bb; sm[r] += (v[r][j][0] + v[r][j][1]) + (v[r][j][2] + v[r][j][3]); } }
#pragma unroll
                for (int r = 0; r < 2; ++r) { const float mean = wave_sum(sm[r]) * (1.f / 2048.f); float s2 = 0.f;
#pragma unroll
                    for (int j = 0; j < 8; ++j) { v[r][j] = v[r][j] - mean; s2 += (v[r][j][0] * v[r][j][0] + v[r][j][1] * v[r][j][1]) + (v[r][j][2] * v[r][j][2] + v[r][j][3] * v[r][j][3]); }
                    rstd[r] = 1.f / sqrtf(wave_sum(s2) * (1.f / 2048.f) + EPS); }
#pragma unroll
                for (int j = 0; j < 8; ++j) { const int c = 4 * lane + 256 * j; const f32x4 scv = *(const Gf32x4*)(md + 4 * 2048 + c) + 1.f, sh = *(const Gf32x4*)(md + 3 * 2048 + c);
#pragma unroll
                    for (int r = 0; r < 2; ++r) { const f32x4 x = v[r][j] * rstd[r] * scv + sh; st4bf(VB + (size_t)(row + r) * 2048 + c, x);
                        f32x4 lo_;
#pragma unroll
                        for (int q = 0; q < 4; ++q) lo_[q] = x[q] - __builtin_bit_cast(float, f2bf(x[q]) << 16);
                        st4bf(VLO + (size_t)(row + r) * 2048 + c, lo_); } }
            }
            SEAM_MID();
            { RouterP g{VB, WSP(bf16_t, WS_VLO), WSP(bf16_t, WS_WRT) + (size_t)l * 2 * 256 * 2048, WSP(bf16_t, WS_WRT) + ((size_t)l * 2 + 1) * 256 * 2048, 1024, 2048, 2048};
              SliceOrder S{nMall, G, bid}; EpiRouter E{WSP(float, WS_RP)}; pg8::gemm_phase<RouterP, EpiRouter, SliceOrder>(lds, g, S, E); }
            SEAM_MID();
            LAS unsigned* lcnt = (LAS unsigned*)lds;
            if (tid < 64) lcnt[tid] = 0u;
            __syncthreads();
            for (int row = gw; row < nrows; row += NGW) {
                const GF* rp = WSP(float, WS_RP) + (size_t)row * 80; float lg = 0.f, le = 0.f;
#pragma unroll
                for (int q = 0; q < 6; ++q) { le += rp[(size_t)q * T * 80 + 8 + lane]; if (lane < 8) lg += rp[(size_t)q * T * 80 + lane]; }
                if (lane < 8) lg += b_grp[l * 8 + lane];
                le += b_exp[l * 64 + lane];
                float gl[8];
#pragma unroll
                for (int q = 0; q < 8; ++q) gl[q] = __shfl(lg, q);
                int gi = 0; float gm = gl[0];
#pragma unroll
                for (int q = 1; q < 8; ++q) if (gl[q] > gm) { gm = gl[q]; gi = q; }
                float gs = 0.f;
#pragma unroll
                for (int q = 0; q < 8; ++q) gs += expf(gl[q] - gm);
                const float grp_p = 1.f / gs;
                float el[8];
#pragma unroll
                for (int q = 0; q < 8; ++q) el[q] = __shfl(le, gi * 8 + q);
                int i1 = 0; float v1 = el[0];
#pragma unroll
                for (int q = 1; q < 8; ++q) if (el[q] > v1) { v1 = el[q]; i1 = q; }
                int i2 = -1; float v2 = -3.4e38f;
#pragma unroll
                for (int q = 0; q < 8; ++q) if (q != i1 && el[q] > v2) { v2 = el[q]; i2 = q; }
                const float e2 = expf(v2 - v1), w0 = grp_p / (1.f + e2), w1 = grp_p * e2 / (1.f + e2);
                if (lane == 0) { const int e0 = gi * 8 + i1, e1 = gi * 8 + i2;
                    const int p0 = (int)__hip_atomic_fetch_add(lcnt + e0, 1u, __ATOMIC_RELAXED, __HIP_MEMORY_SCOPE_WORKGROUP), p1 = (int)__hip_atomic_fetch_add(lcnt + e1, 1u, __ATOMIC_RELAXED, __HIP_MEMORY_SCOPE_WORKGROUP);
                    GI* tk = TOPK + (size_t)row * 8; tk[0] = e0; tk[1] = e1; ((GF*)tk)[2] = w0; ((GF*)tk)[3] = w1; tk[4] = p0; tk[5] = p1; }
            }
            __syncthreads();
            if (tid < 64) ctl[CW_HIST + (l * 512 + bid) * 64 + tid] = lcnt[tid];
            __syncthreads();
            SEAM(pb + 5);
        }
        if (IN(pb + 6)) {
            PHASE_PTRS(); PHASE_IDS();
            GI* TE = WSP(int, WS_TE) + l * 256; GI* TV = WSP(int, WS_TE) + 512 + l * 128; GI* TOPK = WSP(int, WS_TOPK); GI* S2T = WSP(int, WS_XG);
            LAS int* soff = (LAS int*)lds;
            LAS int* tot = soff + 64;
            {
                LAS int* part = soff + 256;
                const int e_ = tid & 63, q_ = tid >> 6, b_lo = (G * q_) >> 3, b_hi = (G * (q_ + 1)) >> 3; int pre = 0, t_ = 0;
#pragma unroll 8
                for (int b2 = b_lo; b2 < b_hi; ++b2) { const int cn = (int)ctl[CW_HIST + (l * 512 + b2) * 64 + e_]; pre += b2 < bid ? cn : 0; t_ += cn; }
                part[q_ * 64 + e_] = pre; part[512 + q_ * 64 + e_] = t_;
                __syncthreads();
                if (tid < 64) { int a = 0, b = 0;
#pragma unroll
                    for (int q = 0; q < 8; ++q) { a += part[q * 64 + tid]; b += part[512 + q * 64 + tid]; }
                    soff[tid] = a; tot[tid] = b; }
                __syncthreads();
            }
            LAS int* stf = soff + 128;
            if (tid < 64) {
                const int te_ = tot[tid], nt_ = (te_ + STROWS - 1) / STROWS; int incl = nt_;
#pragma unroll
                for (int d = 1; d < 64; d <<= 1) { const int v_ = __shfl_up(incl, d); if (lane >= d) incl += v_; }
                const int first = incl - nt_; stf[tid] = first;
                if (bid == 0) { for (int q = 0; q < nt_; ++q) { TE[first + q] = tid; const int rem = te_ - STROWS * q; TV[first + q] = rem < STROWS ? rem : STROWS; }
                    if (tid == 63) TE[200] = incl; } }
            __syncthreads();
            const int nrows = nMall * 256;
            for (int row = (tid >> 3) * NGW + bid * NWAVES + (tid & 7); row < nrows; row += 64 * NGW) {
                GI* tk = TOPK + (size_t)row * 8; const int e0 = tk[0], e1 = tk[1], p0 = soff[e0] + tk[4], p1 = soff[e1] + tk[5], s0 = (stf[e0] + p0 / STROWS) * 512 + p0 % STROWS, s1 = (stf[e1] + p1 / STROWS) * 512 + p1 % STROWS;
                tk[6] = s0; tk[7] = s1; S2T[s0] = row; S2T[s1] = row;
            }
            __syncthreads();
            SEAM(pb + 6);
        }
        if (IN(pb + 7)) {
            PHASE_PTRS(); PHASE_IDS();
            const GI* TE = WSP(int, WS_TE) + l * 256;
            mg::moe_gemm<0>(lds, WSP(bf16_t, WS_VB), INP(I_WGU) + (size_t)l * NEXP * 2048 * 1024, WSP(bf16_t, WS_HB), TE, WSP(int, WS_TE) + 512 + l * 128, WSP(int, WS_XG), __hip_atomic_load(TE + 200, __ATOMIC_RELAXED, __HIP_MEMORY_SCOPE_AGENT), G, bid);
            SEAM(pb + 7);
        }
        if (IN(pb + 8)) {
            PHASE_PTRS(); PHASE_IDS();
            const GI* TE = WSP(int, WS_TE) + l * 256;
            mg::moe_gemm<1>(lds, WSP(bf16_t, WS_HB), INP(I_WDN) + (size_t)l * NEXP * 512 * 2048, WSP(bf16_t, WS_YB), TE, WSP(int, WS_TE) + 512 + l * 128, WSP(int, WS_XG), __hip_atomic_load(TE + 200, __ATOMIC_RELAXED, __HIP_MEMORY_SCOPE_AGENT), G, bid);
            SEAM(pb + 8);
        }
        if (IN(pb + 9)) {
            PHASE_PTRS(); PHASE_IDS();
            const GF* MOD = WSP(float, WS_MOD); const GF* modl = MOD + (size_t)l * 5 * 12288; GB* XS = WSP(bf16_t, WS_XS); GB* U = WSP(bf16_t, WS_U); const GI* TOPK = WSP(int, WS_TOPK); const GB* YB = WSP(bf16_t, WS_YB);
            const GF* ln2_g = INP(I_LN2G); const GF* ln2_b = INP(I_LN2B); GF* outp = (GF*)*(const unsigned long long __attribute__((address_space(4)))*)(kp + 240);
            const int nrows = nMall * 256;
            for (int pr = gw; pr < nrows / 2; pr += NGW) {
                const int row = 2 * pr; const int mrow = row < TL ? (row >> 11) : 4; const GF* md = modl + (size_t)mrow * 12288;
                float w0[2], w1[2]; int s0[2], s1[2];
#pragma unroll
                for (int r = 0; r < 2; ++r) { const GI* tk = TOPK + (size_t)(row + r) * 8; w0[r] = ((const GF*)tk)[2]; w1[r] = ((const GF*)tk)[3]; s0[r] = tk[6]; s1[r] = tk[7]; }
                float mu1[2], rs1[2];
#pragma unroll
                for (int r = 0; r < 2; ++r) { const GF* stp = WSP(float, WS_SSQKV) + (size_t)(row + r) * 8; mu1[r] = stp[0]; rs1[r] = stp[1]; }
                f32x4 v[2][8]; float sm[2] = {0.f, 0.f}, rstd[2];
#pragma unroll
                for (int j = 0; j < 8; ++j) { const int c = 4 * lane + 256 * j; const f32x4 g2 = *(const Gf32x4*)(md + 5 * 2048 + c), gg1 = *(const Gf32x4*)(INP(I_LN1G) + l * 2048 + c), bb1 = *(const Gf32x4*)(INP(I_LN1B) + l * 2048 + c);
#pragma unroll
                    for (int r = 0; r < 2; ++r) { const f32x4 y = ld4bf(YB + (size_t)s0[r] * 2048 + c) * w0[r] + ld4bf(YB + (size_t)s1[r] * 2048 + c) * w1[r];
                        v[r][j] = ((ld4h(XS + (size_t)(row + r) * 2048 + c) - mu1[r]) * rs1[r] * gg1 + bb1) * DN_ALPHA + g2 * y; sm[r] += (v[r][j][0] + v[r][j][1]) + (v[r][j][2] + v[r][j][3]); } }
#pragma unroll
                for (int r = 0; r < 2; ++r) { const float mean = wave_sum(sm[r]) * (1.f / 2048.f); float s2 = 0.f;
#pragma unroll
                    for (int j = 0; j < 8; ++j) { v[r][j] = v[r][j] - mean; s2 += (v[r][j][0] * v[r][j][0] + v[r][j][1] * v[r][j][1]) + (v[r][j][2] * v[r][j][2] + v[r][j][3] * v[r][j][3]); }
                    rstd[r] = 1.f / sqrtf(wave_sum(s2) * (1.f / 2048.f) + EPS); sm[r] = 0.f; }
#pragma unroll
                for (int j = 0; j < 8; ++j) { const int c = 4 * lane + 256 * j; const f32x4 gg = *(const Gf32x4*)(ln2_g + l * 2048 + c), bb = *(const Gf32x4*)(ln2_b + l * 2048 + c);
#pragma unroll
                    for (int r = 0; r < 2; ++r) { v[r][j] = v[r][j] * rstd[r] * gg + bb; sm[r] += (v[r][j][0] + v[r][j][1]) + (v[r][j][2] + v[r][j][3]);
                        if (last) *(Gf32x4*)(outp + (size_t)(row + r) * 2048 + c) = v[r][j]; else st4h(XS + (size_t)(row + r) * 2048 + c, v[r][j]); } }
                if (!last) {
                    const GF* mn = MOD + ((size_t)(l + 1) * 5 + mrow) * 12288;
#pragma unroll
                    for (int r = 0; r < 2; ++r) { const float mean = wave_sum(sm[r]) * (1.f / 2048.f); float s2 = 0.f;
#pragma unroll
                        for (int j = 0; j < 8; ++j) { v[r][j] = v[r][j] - mean; s2 += (v[r][j][0] * v[r][j][0] + v[r][j][1] * v[r][j][1]) + (v[r][j][2] * v[r][j][2] + v[r][j][3] * v[r][j][3]); }
                        rstd[r] = 1.f / sqrtf(wave_sum(s2) * (1.f / 2048.f) + EPS); }
#pragma unroll
                    for (int j = 0; j < 8; ++j) { const int c = 4 * lane + 256 * j; const f32x4 scv = *(const Gf32x4*)(mn + 2048 + c) + 1.f, sh = *(const Gf32x4*)(mn + c);
#pragma unroll
                        for (int r = 0; r < 2; ++r) st4bf(U + (size_t)(row + r) * 2048 + c, v[r][j] * rstd[r] * scv + sh); }
                }
            }
            SEAM(pb + 9);
        }
    }
#undef IN
#undef SEAM
}


extern "C" void kernel_launch(void* const* d_in, const int* in_sizes, int n_in, void* d_out, int out_size, void* d_ws, size_t ws_size, hipStream_t stream) {
    static int grid = 0;
    if (grid == 0) {
        if (n_in != 30 || out_size != TL * D || ws_size < WS_END) { fprintf(stderr, "kernel_launch: unexpected shapes (n_in %d out %d ws %zu need %zu)\n", n_in, out_size, ws_size, (size_t)WS_END); grid = -1; return; }
        int dev = 0, cus = 0, per_cu = 0;
        if (hipGetDevice(&dev) != hipSuccess || hipDeviceGetAttribute(&cus, hipDeviceAttributeMultiprocessorCount, dev) != hipSuccess) { grid = -1; return; }
        if (hipFuncSetAttribute((const void*)fwd, hipFuncAttributeMaxDynamicSharedMemorySize, LDS_BYTES) != hipSuccess) { fprintf(stderr, "kernel_launch: hipFuncSetAttribute failed\n"); grid = -1; return; }
        if (hipOccupancyMaxActiveBlocksPerMultiprocessor(&per_cu, (const void*)fwd, NWAVES * 64, LDS_BYTES) != hipSuccess || per_cu < 1) fprintf(stderr, "kernel_launch: occupancy query reports %d\n", per_cu);
        (void)hipGetLastError();
        grid = cus;
    }
    if (grid < 0) return;
    (void)hipMemsetAsync((char*)d_ws + WS_CTL, 0, CTL_BYTES, stream);
    Args a{};
    for (int i = 0; i < 30; ++i) a.in[i] = (const float*)d_in[i];
    a.out = (float*)d_out; a.ws = (unsigned char*)d_ws;
#if MK_N_LAUNCHES == 1
#if defined(DBG_PREFIX)
    a.ph_lo = 0; a.ph_hi = DBG_PREFIX; a.region = 1; hipLaunchKernelGGL(fwd, dim3(grid), dim3(NWAVES * 64), LDS_BYTES, stream, a);
#endif
    a.ph_lo = 0; a.ph_hi = NPHASE; a.region = 0;
    hipLaunchKernelGGL(fwd, dim3(grid), dim3(NWAVES * 64), LDS_BYTES, stream, a);
#else
    for (int p = 0; p < NPHASE; ++p) { a.ph_lo = p; a.ph_hi = p + 1; hipLaunchKernelGGL(fwd, dim3(grid), dim3(NWAVES * 64), LDS_BYTES, stream, a); }
#endif
    const hipError_t le = hipPeekAtLastError();
    if (le != hipSuccess) fprintf(stderr, "kernel_launch: launch failed: %s\n", hipGetErrorName(le));
}
```

```cpp
#include <hip/hip_runtime.h>
#include <cstdio>
#include <cstdint>

#ifndef MK_N_LAUNCHES
#define MK_N_LAUNCHES 1
#endif

#define GAS __attribute__((address_space(1)))
#define LAS __attribute__((address_space(3)))
typedef unsigned short bf16_t;
typedef short bf16x8 __attribute__((ext_vector_type(8)));
typedef short s16x4 __attribute__((ext_vector_type(4)));
typedef float f32x4 __attribute__((ext_vector_type(4)));
typedef float f32x16 __attribute__((ext_vector_type(16)));
typedef unsigned u32x4 __attribute__((ext_vector_type(4)));
typedef unsigned u32x2 __attribute__((ext_vector_type(2)));
typedef GAS bf16_t GB; typedef GAS float GF; typedef GAS int GI; typedef GAS unsigned GU; typedef GAS unsigned char GC;
typedef GAS f32x4 Gf32x4; typedef GAS u32x4 Gu32x4; typedef GAS u32x2 Gu32x2; typedef GAS bf16x8 Gbf16x8;
typedef __attribute__((address_space(4))) const unsigned char CKA;

constexpr int D = 2048, NB = 4, SEQ = 2048, CTX = 256, NL = 2;
constexpr int TL = NB * SEQ, TC = NB * CTX, T = TL + TC;
constexpr int NP = 9728;
constexpr int IN_COLS = 9536;
constexpr int NEXP = 64, DEXP = 512;
constexpr int STROWS = 384, MAXST = 112, MAXSLOTS = MAXST * 512;
constexpr float EPS = 1e-6f;
constexpr float DN_ALPHA = 1.4142135623730951f;
constexpr float LOG2E = 1.4426950408889634f;

__device__ __forceinline__ unsigned f2bf(float f) { unsigned u = __builtin_bit_cast(unsigned, f); return (u + 0x7fffu + ((u >> 16) & 1u)) >> 16; }
__device__ __forceinline__ unsigned pk2(float lo, float hi) { return f2bf(lo) | (f2bf(hi) << 16); }
__device__ __forceinline__ float bf2f(unsigned short b) { return __builtin_bit_cast(float, ((unsigned)b) << 16); }
__device__ __forceinline__ float bflo(unsigned w) { return __builtin_bit_cast(float, w << 16); }
__device__ __forceinline__ float bfhi(unsigned w) { return __builtin_bit_cast(float, w & 0xffff0000u); }
typedef float f32x2_t __attribute__((ext_vector_type(2)));
typedef __bf16 bf16x2_t __attribute__((ext_vector_type(2)));
__device__ __forceinline__ unsigned cvt_pk_bf16(float lo, float hi) { f32x2_t v = {lo, hi}; bf16x2_t b = __builtin_convertvector(v, bf16x2_t); return __builtin_bit_cast(unsigned, b); }
__device__ __forceinline__ void st4bf(GB* p, f32x4 v) { u32x2 w; w.x = cvt_pk_bf16(v[0], v[1]); w.y = cvt_pk_bf16(v[2], v[3]); *(Gu32x2*)p = w; }
__device__ __forceinline__ f32x4 ld4bf(const GB* p) { const u32x2 w = *(const Gu32x2*)p; return (f32x4){bflo(w.x), bfhi(w.x), bflo(w.y), bfhi(w.y)}; }
__device__ __forceinline__ float wave_sum(float v) {
#pragma unroll
    for (int o = 1; o < 64; o <<= 1) v += __shfl_xor(v, o);
    return v;
}

namespace pg8 {
constexpr int BM = 256, BK = 64, HALF = 128, HTB = HALF * BK * 2, STAGE_BYTES = 8 * HTB, NXCD = 8, WGM = 8;
__host__ __device__ __forceinline__ int lds_byte(int r, int c) { const int st = (r >> 4) * 2 + (c >> 5), rr = r & 15, cc = c & 31, ob = rr * 64 + cc * 2; return st * 1024 + (ob ^ (((ob >> 9) & 1) << 5)); }
__host__ __device__ __forceinline__ void stage_rc(int b, int& R, int& C) { const int st = b / 1024, sb = b % 1024, swz = sb ^ (((sb >> 9) & 1) << 5); R = (st >> 1) * 16 + swz / 64; C = (st & 1) * 32 + (swz % 64) / 2; }

struct Unit { int pm, pn, ex; };

struct Plain {
    const GB* A; const GB* Bt; int K, lda, ldb; static constexpr int kstepB = BK * 2;
    __device__ __forceinline__ const GAS char* aptr(const Unit& u) const { return (const GAS char*)(A + (size_t)u.pm * BM * lda); }
    __device__ __forceinline__ const GAS char* bptr(const Unit& u) const { return (const GAS char*)(Bt + (size_t)u.pn * BM * ldb); }
};
struct Grouped {
    const GB* A; const GB* Bt; int K, lda; size_t estride; static constexpr int ldb = 64, kstepB = 256 * 64 * 2;
    __device__ __forceinline__ const GAS char* aptr(const Unit& u) const { return (const GAS char*)(A + (size_t)u.pm * BM * lda); }
    __device__ __forceinline__ const GAS char* bptr(const Unit& u) const { return (const GAS char*)(Bt + (size_t)u.ex * estride + (size_t)u.pn * (K / 64) * 256 * 64); }
};

struct RectOrder {
    int nM, nN, nwg, G, c, pm0b, nMb, nNb, nwgb, rot, rot0;
    __device__ void init(int nM_, int nN_, int G_, int c_, int pm0b_ = 0, int nMb_ = 0, int nNb_ = 0) { nM = nM_; nN = nN_; nwg = nM * nN; G = G_; c = c_; pm0b = pm0b_; nMb = nMb_; nNb = nNb_; nwgb = nMb * nNb; rot = 0; rot0 = 0; }
    __device__ bool next(int i, Unit& u) const {
        const int L = i * G + (c - (i == 0 ? rot0 : rot) + G) % G; u.ex = i == 0 ? 0 : 1 + (L - G);
        if (L < nwg) {
            int wgid = L; { const int q = nwg / NXCD, r = nwg % NXCD, xcd = wgid % NXCD, off = wgid / NXCD; wgid = (xcd < r ? xcd * (q + 1) : r * (q + 1) + (xcd - r) * q) + off; }
            const int nig = WGM * nN, gid = wgid / nig, fm = gid * WGM, gsz = (nM - fm) < WGM ? (nM - fm) : WGM;
            u.pm = fm + ((wgid % nig) % gsz); u.pn = (wgid % nig) / gsz; return true;
        }
        const int L2 = L - nwg; if (L2 >= nwgb) return false;
        u.pm = pm0b + L2 % nMb; u.pn = L2 / nMb; return true;
    }
};
struct TileOrder {
    const GI* te; int ntiles, nN, G, c;
    __device__ bool next(int i, Unit& u) const {
        const int tpr = G / nN;
        int tl, pn;
        if ((G & 7) == 0 && (tpr & 7) == 0) { const int x = c & 7, sl = c >> 3; tl = x * (tpr >> 3) + sl / nN; pn = sl % nN; }
        else { tl = c / nN; pn = c % nN; if (tl >= tpr) return false; }
        const int pm = i * tpr + tl; if (pm >= ntiles) return false;
        u.pm = pm; u.pn = pn; u.ex = __hip_atomic_load(te + pm, __ATOMIC_RELAXED, __HIP_MEMORY_SCOPE_AGENT); return true;
    }
};

template <class Prob, class Epi, class Sched, bool ALIGN_EPI = true, bool SP2 = true>
__device__ __forceinline__ void gemm_phase_stream(LAS unsigned char* lds, const Prob g, const Sched& S, const Epi& E) {
    int tid_ = threadIdx.x; asm volatile("" : "+v"(tid_));
    const int tid = tid_, wid = __builtin_amdgcn_readfirstlane(tid >> 6), lane = tid & 63, wr = wid >> 2, wc = wid & 3, fr = lane & 15, fq = lane >> 4;
    const int K = g.K, nt = K / BK;
    unsigned voffA[2], voffB[2];
#pragma unroll
    for (int i = 0; i < 2; ++i) { int R, C; stage_rc(tid * 16 + i * 8192, R, C); voffA[i] = (unsigned)(R * g.lda + C) * 2u; voffB[i] = (unsigned)(R * g.ldb + C) * 2u; }
    const size_t kstep = (size_t)(BK * 2), kstepB = (size_t)g.kstepB;
    const size_t hstepA = (size_t)HALF * g.lda * 2, hstepB = (size_t)HALF * g.ldb * 2;
    const unsigned ldsw = (unsigned)wid * 1024u;
    const int aoff = lds_byte(wr * 64 + fr, fq * 8), boff = lds_byte(wc * 32 + fr, fq * 8);
#define PG8_SA(b, h) (((b) * 2 + (h)) * HTB)
#define PG8_SB(b, h) ((4 + (b) * 2 + (h)) * HTB)
#define PG8_STAGE(bufoff, gbase, voff) do { _Pragma("unroll") for (int _i = 0; _i < 2; ++_i) \
        __builtin_amdgcn_global_load_lds((const unsigned*)((const GAS char*)(gbase) + (voff)[_i]), (LAS unsigned*)(lds + (bufoff) + ldsw + _i * 8192), 16, 0, 0); } while (0)
#define PG8_LDA(dst, b, h) do { _Pragma("unroll") for (int m = 0; m < 4; ++m) _Pragma("unroll") for (int k = 0; k < 2; ++k) dst[m][k] = *(const LAS bf16x8*)(lds + PG8_SA(b, h) + aoff + m * 2048 + k * 1024); } while (0)
#define PG8_LDB(dst, b, h) do { _Pragma("unroll") for (int n = 0; n < 2; ++n) _Pragma("unroll") for (int k = 0; k < 2; ++k) dst[n][k] = *(const LAS bf16x8*)(lds + PG8_SB(b, h) + boff + n * 2048 + k * 1024); } while (0)
#define PG8_MMA(ai, bj, At, Bt) do { __builtin_amdgcn_s_setprio(1); _Pragma("unroll") for (int m = 0; m < 4; ++m) _Pragma("unroll") for (int n = 0; n < 2; ++n) _Pragma("unroll") for (int k = 0; k < 2; ++k) \
        acc[ai][bj][m][n] = __builtin_amdgcn_mfma_f32_16x16x32_bf16(Bt[n][k], At[m][k], acc[ai][bj][m][n], 0, 0, 0); __builtin_amdgcn_s_setprio(0); } while (0)
#define PG8_WAIT_V(n) asm volatile("s_waitcnt vmcnt(" #n ")" ::: "memory")
#define PG8_WAIT_L(n) asm volatile("s_waitcnt lgkmcnt(" #n ")" ::: "memory")
#define PG8_BAR __builtin_amdgcn_s_barrier()
#define PG8_SCHED __builtin_amdgcn_sched_barrier(0)
    Unit cur, nxt; int ui = 0;
    if (!S.next(0, cur)) return;
    f32x4 acc[2][2][4][2];
#pragma unroll
    for (int a = 0; a < 2; ++a)
#pragma unroll
        for (int b = 0; b < 2; ++b)
#pragma unroll
            for (int m = 0; m < 4; ++m)
#pragma unroll
                for (int n = 0; n < 2; ++n) acc[a][b][m][n] = (f32x4){0.f, 0.f, 0.f, 0.f};
    bf16x8 At[4][2], B0[2][2], B1[2][2];
    const GAS char* cA = g.aptr(cur); const GAS char* cB = g.bptr(cur);
    if constexpr (SP2) {
        PG8_STAGE(PG8_SB(0, 0), cB, voffB); PG8_STAGE(PG8_SB(0, 1), cB + hstepB, voffB); PG8_STAGE(PG8_SA(0, 0), cA, voffA); PG8_STAGE(PG8_SA(0, 1), cA + hstepA, voffA);
        if (wr == 1) PG8_BAR;
        PG8_WAIT_V(2); PG8_BAR;
        PG8_STAGE(PG8_SB(1, 0), cB + kstepB, voffB); PG8_STAGE(PG8_SA(1, 0), cA + kstep, voffA); PG8_STAGE(PG8_SB(1, 1), cB + hstepB + kstepB, voffB);
        PG8_WAIT_V(6); PG8_BAR;
    } else {
        PG8_STAGE(PG8_SB(0, 0), cB, voffB); PG8_STAGE(PG8_SA(0, 0), cA, voffA); PG8_STAGE(PG8_SB(0, 1), cB + hstepB, voffB); PG8_STAGE(PG8_SA(0, 1), cA + hstepA, voffA);
        if (wr == 1) PG8_BAR;
        PG8_WAIT_V(4); PG8_BAR;
        PG8_STAGE(PG8_SB(1, 0), cB + kstepB, voffB); PG8_STAGE(PG8_SA(1, 0), cA + kstep, voffA); PG8_STAGE(PG8_SB(1, 1), cB + hstepB + kstepB, voffB);
        PG8_WAIT_V(6); PG8_BAR;
    }
    for (;;) {
        const bool has_next = S.next(ui + 1, nxt);
        const GAS char* nA = has_next ? g.aptr(nxt) : cA; const GAS char* nB = has_next ? g.bptr(nxt) : cB;
        for (int t = 0; t < nt; t += 2) {
            const bool last = (t == nt - 2);
            const GAS char* a1 = cA + (size_t)(t + 1) * kstep;
            const GAS char* a2 = last ? nA : cA + (size_t)(t + 2) * kstep; const GAS char* b2 = last ? nB : cB + (size_t)(t + 2) * kstepB;
            const GAS char* a3 = a2 + kstep; const GAS char* b3 = b2 + kstepB;
            if constexpr (SP2) {
            PG8_LDB(B0, 0, 0); PG8_LDB(B1, 0, 1); PG8_SCHED; PG8_LDA(At, 0, 0); PG8_STAGE(PG8_SA(1, 1), a1 + hstepA, voffA);
            PG8_WAIT_V(8); PG8_WAIT_L(0); PG8_BAR; PG8_MMA(0, 0, At, B0); PG8_MMA(0, 1, At, B1); PG8_BAR; PG8_SCHED;
            PG8_LDA(At, 0, 1); PG8_STAGE(PG8_SB(0, 0), b2, voffB); PG8_STAGE(PG8_SB(0, 1), b2 + hstepB, voffB); PG8_STAGE(PG8_SA(0, 0), a2, voffA);
            PG8_WAIT_V(8); PG8_WAIT_L(0); PG8_BAR; PG8_MMA(1, 0, At, B0); PG8_MMA(1, 1, At, B1); PG8_BAR; PG8_SCHED;
            PG8_LDB(B0, 1, 0); PG8_LDB(B1, 1, 1); PG8_SCHED; PG8_LDA(At, 1, 0); PG8_STAGE(PG8_SA(0, 1), a2 + hstepA, voffA);
            PG8_WAIT_V(8); PG8_WAIT_L(0); PG8_BAR; PG8_MMA(0, 0, At, B0); PG8_MMA(0, 1, At, B1); PG8_BAR; PG8_SCHED;
            PG8_LDA(At, 1, 1); PG8_STAGE(PG8_SB(1, 0), b3, voffB); PG8_STAGE(PG8_SB(1, 1), b3 + hstepB, voffB); PG8_STAGE(PG8_SA(1, 0), a3, voffA);
            PG8_WAIT_V(8); PG8_WAIT_L(0); PG8_BAR; PG8_MMA(1, 0, At, B0); PG8_MMA(1, 1, At, B1); PG8_BAR; PG8_SCHED;
            } else {
            PG8_LDB(B0, 0, 0); PG8_SCHED; PG8_LDA(At, 0, 0); PG8_STAGE(PG8_SA(1, 1), a1 + hstepA, voffA);
            PG8_WAIT_L(8); PG8_BAR; PG8_WAIT_L(0); PG8_MMA(0, 0, At, B0); PG8_BAR; PG8_SCHED;
            PG8_LDB(B1, 0, 1); PG8_STAGE(PG8_SB(0, 0), b2, voffB);
            PG8_BAR; PG8_WAIT_L(0); PG8_MMA(0, 1, At, B1); PG8_BAR;
            PG8_LDA(At, 0, 1); PG8_STAGE(PG8_SA(0, 0), a2, voffA);
            PG8_BAR; PG8_WAIT_L(0); PG8_MMA(1, 0, At, B0); PG8_BAR; PG8_SCHED;
            PG8_STAGE(PG8_SB(0, 1), b2 + hstepB, voffB);
            PG8_WAIT_V(6); PG8_BAR; PG8_MMA(1, 1, At, B1); PG8_BAR;
            PG8_LDB(B0, 1, 0); PG8_SCHED; PG8_LDA(At, 1, 0); PG8_STAGE(PG8_SA(0, 1), a2 + hstepA, voffA);
            PG8_WAIT_L(8); PG8_BAR; PG8_WAIT_L(0); PG8_MMA(0, 0, At, B0); PG8_BAR; PG8_SCHED;
            PG8_LDB(B1, 1, 1); PG8_STAGE(PG8_SB(1, 0), b3, voffB);
            PG8_BAR; PG8_WAIT_L(0); PG8_MMA(0, 1, At, B1); PG8_BAR;
            PG8_LDA(At, 1, 1); PG8_STAGE(PG8_SA(1, 0), a3, voffA);
            PG8_BAR; PG8_WAIT_L(0); PG8_MMA(1, 0, At, B0); PG8_BAR; PG8_SCHED;
            PG8_STAGE(PG8_SB(1, 1), b3 + hstepB, voffB);
            PG8_WAIT_V(6); PG8_BAR; PG8_MMA(1, 1, At, B1); PG8_BAR;
            }
        }
        if constexpr (ALIGN_EPI) { if (wr == 0) PG8_BAR; }
        { int fr2 = fr, fq2 = fq; asm volatile("" : "+v"(fr2), "+v"(fq2)); E(acc, cur, wr, wc, fr2, fq2); }
        if (!has_next) break;
#pragma unroll
        for (int a = 0; a < 2; ++a)
#pragma unroll
            for (int b = 0; b < 2; ++b)
#pragma unroll
                for (int m = 0; m < 4; ++m)
#pragma unroll
                    for (int n = 0; n < 2; ++n) acc[a][b][m][n] = (f32x4){0.f, 0.f, 0.f, 0.f};
        cur = nxt; cA = nA; cB = nB; ++ui;
        if constexpr (ALIGN_EPI) { if (wr == 1) PG8_BAR; }
    }
    PG8_WAIT_V(0);
    if constexpr (!ALIGN_EPI) { if (wr == 0) PG8_BAR; }
    PG8_BAR;
#undef PG8_SA
#undef PG8_SB
#undef PG8_STAGE
#undef PG8_LDA
#undef PG8_LDB
#undef PG8_MMA
#undef PG8_WAIT_V
#undef PG8_WAIT_L
#undef PG8_BAR
#undef PG8_SCHED
}

struct OneUnit { Unit u; __device__ bool next(int i, Unit& o) const { if (i) return false; o = u; return true; } };
template <class Prob, class Epi, class Sched>
__device__ __forceinline__ void gemm_phase(LAS unsigned char* lds, const Prob g, const Sched& S, const Epi& E) {
#if defined(DBG_ONE_UNIT)
    Unit u; for (int i = 0; S.next(i, u); ++i) { OneUnit O{u}; gemm_phase_stream<Prob, Epi, OneUnit>(lds, g, O, E); }
#else
    gemm_phase_stream<Prob, Epi, Sched>(lds, g, S, E);
#endif
}
}
using pg8::Unit;
typedef const f32x4 (&AccRef)[2][2][4][2];

constexpr size_t al256(size_t x) { return (x + 255) / 256 * 256; }
constexpr size_t WS_CTL = 0, CTL_BYTES = 1u << 20;
constexpr int CW_BAR = 4096;
constexpr int CW_FLG = 20480;
constexpr int CW_CNT = 16384;
constexpr int CW_HIST = 32768;
constexpr size_t WS_MOD = WS_CTL + CTL_BYTES;
constexpr size_t WS_ROPE = WS_MOD + al256((size_t)NL * 5 * 12288 * 4);
constexpr size_t WS_WRT = WS_ROPE + 8192;
constexpr size_t WS_TE = WS_WRT + (size_t)NL * 2 * 256 * 2048 * 2;
constexpr size_t WS_WIN = WS_TE + 4096;
constexpr size_t WS_WUKV = WS_WIN + (size_t)NL * NP * 2048 * 2;
constexpr size_t WS_WUQ = WS_WUKV + (size_t)NL * 2048 * 512 * 2;
constexpr size_t WS_WPL = WS_WUQ + (size_t)NL * 1536 * 768 * 2;
constexpr size_t WS_WBM = WS_WPL + (size_t)NL * 512 * 512 * 2;
constexpr size_t WS_WBD = WS_WBM + (size_t)NL * 2048 * 1024 * 2;
constexpr size_t WS_WBP = WS_WBD + (size_t)NL * 2048 * 512 * 2;
constexpr size_t WS_WO = WS_WBP + (size_t)NL * 2048 * 512 * 2;
constexpr size_t WS_XS = WS_WO + (size_t)NL * 2048 * 2048 * 2;
constexpr size_t WS_U = WS_XS + (size_t)T * 2048 * 4;
constexpr size_t WS_CKV = WS_U + (size_t)T * 2048 * 2;
constexpr size_t WS_KD = WS_CKV + (size_t)T * 512 * 2;
constexpr size_t WS_VD = WS_KD + (size_t)T * 512 * 2;
constexpr size_t WS_KR = WS_VD + (size_t)T * 512 * 2;
constexpr size_t WS_CQ = WS_KR + (size_t)T * 64 * 2;
constexpr size_t WS_QD = WS_CQ + (size_t)T * 768 * 2;
constexpr size_t WS_PIN = WS_QD + (size_t)T * 512 * 2;
constexpr size_t WS_GT = WS_PIN + (size_t)T * 512 * 2;
constexpr size_t WS_SSQKV = WS_GT + (size_t)T * 6144 * 2;
constexpr size_t WS_SSQQ = WS_SSQKV + (size_t)T * 8 * 4;
constexpr size_t WS_KN = WS_SSQQ + al256((size_t)T * 12 * 4);
constexpr size_t WS_VM = WS_KN + (size_t)T * 1024 * 2;
constexpr size_t WS_QM = WS_VM + (size_t)T * 1024 * 2;
constexpr size_t WS_PL = WS_QM + (size_t)T * 1536 * 2;
constexpr size_t WS_OP = WS_PL + (size_t)T * 512 * 2;
constexpr size_t WS_OM = WS_OP + (size_t)T * 512 * 2;
constexpr size_t WS_OD = WS_OM + (size_t)T * 1024 * 2;
constexpr size_t WS_MG = WS_OD + (size_t)T * 512 * 2;
constexpr size_t WS_VB = WS_MG + (size_t)T * 2048 * 2;
constexpr size_t WS_TOPK = WS_VB + (size_t)T * 2048 * 2;
constexpr size_t WS_XG = WS_TOPK + (size_t)T * 32;
constexpr size_t WS_HB = WS_XG + (size_t)MAXSLOTS * 2048 * 2;
constexpr size_t WS_YB = WS_HB + (size_t)MAXSLOTS * 512 * 2;
constexpr size_t WS_VLO = WS_YB + (size_t)MAXSLOTS * 2048 * 2;
constexpr size_t WS_RP = WS_VLO + (size_t)T * 2048 * 2;
constexpr size_t WS_END = WS_RP + (size_t)6 * T * 80 * 4;

struct EpiIn {
    GC* wsb; const GF* bgate;
    __device__ __forceinline__ void operator()(AccRef acc, const Unit& u, int wr, int wc, int fr, int fq) const {
        unsigned wlo_ = (unsigned)(size_t)wsb, whi_ = (unsigned)((size_t)wsb >> 32); asm volatile("" : "+v"(wlo_), "+v"(whi_));
        GC* w_ = (GC*)(((size_t)(unsigned)__builtin_amdgcn_readfirstlane(whi_) << 32) | (size_t)(unsigned)__builtin_amdgcn_readfirstlane(wlo_));
        GB*CKV = (GB*)(w_ + WS_CKV), *KD = (GB*)(w_ + WS_KD), *VD = (GB*)(w_ + WS_VD), *KR = (GB*)(w_ + WS_KR), *CQ = (GB*)(w_ + WS_CQ), *QD = (GB*)(w_ + WS_QD), *PIN = (GB*)(w_ + WS_PIN), *GT = (GB*)(w_ + WS_GT);
        GF*SSQKV = (GF*)(w_ + WS_SSQKV), *SSQQ = (GF*)(w_ + WS_SSQQ); const GF*ropec = (const GF*)(w_ + WS_ROPE), *ropes = ropec + 1024;
        const int pn = u.pn, row0 = u.pm * 256 + wr * 64 + fr, cw = wc * 32 + 4 * fq;
        const bool lat = u.pm < 32;
        if (pn < 2 || (pn >= 7 && pn < 10)) {
            const bool iskv = pn < 2; const int t0 = iskv ? pn : pn - 7; GB* dst = iskv ? CKV : CQ; const int ldd = iskv ? 512 : 768;
            GF* ssq = iskv ? SSQKV : SSQQ; const int nss = iskv ? 8 : 12;
#pragma unroll
            for (int ai = 0; ai < 2; ++ai)
#pragma unroll
                for (int m = 0; m < 4; ++m) { const int row = row0 + ai * 128 + m * 16; float s = 0.f;
#pragma unroll
                    for (int bj = 0; bj < 2; ++bj)
#pragma unroll
                        for (int n = 0; n < 2; ++n) { const f32x4 v = acc[ai][bj][m][n]; s += (v[0] * v[0] + v[1] * v[1]) + (v[2] * v[2] + v[3] * v[3]);
                            st4bf(dst + (size_t)row * ldd + t0 * 256 + bj * 128 + cw + 16 * n, v); }
                    s += __shfl_xor(s, 16); s += __shfl_xor(s, 32);
                    if (fq == 0) ssq[(size_t)row * nss + t0 * 4 + wc] = s; }
        } else if (pn < 4 || pn == 6 || (pn >= 10 && pn < 12)) {
            if (pn == 6 && wc >= 2) return;
            const int half = wc & 1;
            GB* dst; int ldd, c0;
            if (pn < 4) { dst = KD; ldd = 512; c0 = (pn - 2) * 256; } else if (pn == 6) { dst = KR; ldd = 64; c0 = 0; } else { dst = QD; ldd = 512; c0 = (pn - 10) * 256; }
#pragma unroll
            for (int ai = 0; ai < 2; ++ai)
#pragma unroll
                for (int m = 0; m < 4; ++m) { const int row = row0 + ai * 128 + m * 16;
                    f32x4 cs = (f32x4){1.f, 1.f, 1.f, 1.f}, sn = (f32x4){0.f, 0.f, 0.f, 0.f};
                    if (lat) { const int t = row & 2047, pos = half ? (t & 63) : (t >> 6); cs = *(const Gf32x4*)(ropec + pos * 16 + 4 * fq); sn = *(const Gf32x4*)(ropes + pos * 16 + 4 * fq); }
#pragma unroll
                    for (int bj = 0; bj < 2; ++bj) { if (pn == 6 && bj == 1) continue;
                        const f32x4 x1 = acc[ai][bj][m][0], x2 = acc[ai][bj][m][1];
                        const f32x4 o1 = x1 * cs - x2 * sn, o2 = x2 * cs + x1 * sn;
                        GB* p = dst + (size_t)row * ldd + c0 + bj * 128 + cw;
                        st4bf(p, o1); st4bf(p + 16, o2); } }
        } else if (pn < 6 || pn < 14) {
            GB* dst = pn < 6 ? VD : PIN; const int c0 = (pn < 6 ? pn - 4 : pn - 12) * 256;
#pragma unroll
            for (int ai = 0; ai < 2; ++ai)
#pragma unroll
                for (int m = 0; m < 4; ++m) { const int row = row0 + ai * 128 + m * 16;
#pragma unroll
                    for (int bj = 0; bj < 2; ++bj)
#pragma unroll
                        for (int n = 0; n < 2; ++n) st4bf(dst + (size_t)row * 512 + c0 + bj * 128 + cw + 16 * n, acc[ai][bj][m][n]); }
        } else {
            const int c0 = (pn - 14) * 256;
            f32x4 bv[2][2];
#pragma unroll
            for (int bj = 0; bj < 2; ++bj)
#pragma unroll
                for (int n = 0; n < 2; ++n) bv[bj][n] = *(const Gf32x4*)(bgate + c0 + bj * 128 + cw + 16 * n);
#pragma unroll
            for (int ai = 0; ai < 2; ++ai)
#pragma unroll
                for (int m = 0; m < 4; ++m) { const int row = row0 + ai * 128 + m * 16;
#pragma unroll
                    for (int bj = 0; bj < 2; ++bj)
#pragma unroll
                        for (int n = 0; n < 2; ++n) { f32x4 v = acc[ai][bj][m][n] + bv[bj][n];
#pragma unroll
                            for (int j = 0; j < 4; ++j) v[j] = __builtin_amdgcn_rcpf(1.f + __builtin_amdgcn_exp2f(-LOG2E * v[j]));
                            st4bf(GT + (size_t)row * 6144 + c0 + bj * 128 + cw + 16 * n, v); } }
        }
    }
};
struct EpiKV {
    GB*KN, *VM; const GF* SSQKV;
    __device__ __forceinline__ void operator()(AccRef acc, const Unit& u, int wr, int wc, int fr, int fq) const {
        const int row0 = u.pm * 256 + wr * 64 + fr, cw = wc * 32 + 4 * fq;
#pragma unroll
        for (int ai = 0; ai < 2; ++ai)
#pragma unroll
            for (int m = 0; m < 4; ++m) { const int row = row0 + ai * 128 + m * 16;
                const f32x4 s0 = *(const Gf32x4*)(SSQKV + (size_t)row * 8), s1 = *(const Gf32x4*)(SSQKV + (size_t)row * 8 + 4);
                const float ss = ((s0[0] + s0[1]) + (s0[2] + s0[3])) + ((s1[0] + s1[1]) + (s1[2] + s1[3]));
                const float r = 1.f / sqrtf(ss * (1.f / 512.f) + EPS);
#pragma unroll
                for (int n = 0; n < 2; ++n) { st4bf(KN + (size_t)row * 1024 + u.pn * 128 + cw + 16 * n, acc[ai][0][m][n] * r); st4bf(VM + (size_t)row * 1024 + u.pn * 128 + cw + 16 * n, acc[ai][1][m][n] * r); } }
    }
};
struct EpiQ {
    GB* QM; const GF*SSQQ, *ropec, *ropes;
    __device__ __forceinline__ void operator()(AccRef acc, const Unit& u, int wr, int wc, int fr, int fq) const {
        const int row0 = u.pm * 256 + wr * 64 + fr; const bool lat = u.pm < 32;
#pragma unroll
        for (int ai = 0; ai < 2; ++ai)
#pragma unroll
            for (int m = 0; m < 4; ++m) { const int row = row0 + ai * 128 + m * 16;
                const f32x4 s0 = *(const Gf32x4*)(SSQQ + (size_t)row * 12), s1 = *(const Gf32x4*)(SSQQ + (size_t)row * 12 + 4), s2 = *(const Gf32x4*)(SSQQ + (size_t)row * 12 + 8);
                const float ss = ((s0[0] + s0[1]) + (s0[2] + s0[3])) + ((s1[0] + s1[1]) + (s1[2] + s1[3])) + ((s2[0] + s2[1]) + (s2[2] + s2[3]));
                const float r = 1.f / sqrtf(ss * (1.f / 768.f) + EPS);
#pragma unroll
                for (int bj = 0; bj < 2; ++bj) { const int cb = u.pn * 256 + bj * 128 + wc * 32, w0 = cb % 192;
                    f32x4 x1 = acc[ai][bj][m][0] * r, x2 = acc[ai][bj][m][1] * r;
                    if (w0 >= 128 && lat) { const int t = row & 2047, pos = (w0 >= 160) ? (t & 63) : (t >> 6);
                        const f32x4 cs = *(const Gf32x4*)(ropec + pos * 16 + 4 * fq), sn = *(const Gf32x4*)(ropes + pos * 16 + 4 * fq);
                        const f32x4 o1 = x1 * cs - x2 * sn, o2 = x2 * cs + x1 * sn; x1 = o1; x2 = o2; }
                    GB* p = QM + (size_t)row * 1536 + cb + 4 * fq; st4bf(p, x1); st4bf(p + 16, x2); } }
    }
};
struct EpiBf {
    GB* O; int ldc;
    __device__ __forceinline__ void operator()(AccRef acc, const Unit& u, int wr, int wc, int fr, int fq) const {
        const int row0 = u.pm * 256 + wr * 64 + fr, col0 = u.pn * 256 + wc * 32 + 4 * fq;
#pragma unroll
        for (int ai = 0; ai < 2; ++ai)
#pragma unroll
            for (int m = 0; m < 4; ++m) { GB* rp = O + (size_t)(row0 + ai * 128 + m * 16) * ldc + col0;
#pragma unroll
                for (int bj = 0; bj < 2; ++bj)
#pragma unroll
                    for (int n = 0; n < 2; ++n) st4bf(rp + bj * 128 + 16 * n, acc[ai][bj][m][n]); }
    }
};
template <int STEP> struct EpiMerge {
    GB* MG; const GB* GT; GU* flg;
    __device__ __forceinline__ void operator()(AccRef acc, const Unit& u, int wr, int wc, int fr, int fq) const {
        const int row0 = u.pm * 256 + wr * 64 + fr, col0 = u.pn * 256 + wc * 32 + 4 * fq;
        if (STEP > 0 && u.ex > 0) {
            GU* f = flg + (STEP - 1) * 512 + (u.ex - 1); unsigned sp = 0u;
            while (__hip_atomic_load(f, __ATOMIC_RELAXED, __HIP_MEMORY_SCOPE_AGENT) < 8u) { __builtin_amdgcn_s_sleep(2); if (++sp > (1u << 24)) break; }
            __builtin_amdgcn_fence(__ATOMIC_ACQUIRE, "agent");
        }
#pragma unroll
        for (int ai = 0; ai < 2; ++ai)
#pragma unroll
            for (int m = 0; m < 4; ++m) { const int row = row0 + ai * 128 + m * 16;
#pragma unroll
                for (int bj = 0; bj < 2; ++bj)
#pragma unroll
                    for (int n = 0; n < 2; ++n) { const int col = col0 + bj * 128 + 16 * n;
                        const f32x4 gt = ld4bf(GT + (size_t)row * 6144 + STEP * 2048 + col); f32x4 v = gt * acc[ai][bj][m][n];

                        GB* p = MG + (size_t)row * 2048 + col; if (STEP > 0) v = v + ld4bf(p); st4bf(p, v); } }
        if (STEP < 2 && u.ex > 0) {
            __builtin_amdgcn_fence(__ATOMIC_RELEASE, "agent");
            if ((fr | fq) == 0) (void)__hip_atomic_fetch_add(flg + STEP * 512 + (u.ex - 1), 1u, __ATOMIC_RELAXED, __HIP_MEMORY_SCOPE_AGENT);
        }
    }
};
struct EpiWo {
    GB* XS; const GF* modl; const GF* srcL; const GF* srcC; bool f32src;
    __device__ __forceinline__ void operator()(AccRef acc, const Unit& u, int wr, int wc, int fr, int fq) const {
        const int row0 = u.pm * 256 + wr * 64 + fr, col0 = u.pn * 256 + wc * 32 + 4 * fq;
        const int mrow = u.pm < 32 ? (u.pm >> 3) : 4; const GF* g1 = modl + (size_t)mrow * 12288 + 2 * 2048;
        f32x4 gv[2][2];
#pragma unroll
        for (int bj = 0; bj < 2; ++bj)
#pragma unroll
            for (int n = 0; n < 2; ++n) gv[bj][n] = *(const Gf32x4*)(g1 + col0 + bj * 128 + 16 * n);
#pragma unroll
        for (int ai = 0; ai < 2; ++ai)
#pragma unroll
            for (int m = 0; m < 4; ++m) { GB* rp = XS + (size_t)(row0 + ai * 128 + m * 16) * 2048 + col0; const GF* sp = (u.pm < 32 ? srcL : srcC) + (size_t)(row0 + ai * 128 + m * 16) * 2048 + col0;
#pragma unroll
                for (int bj = 0; bj < 2; ++bj)
#pragma unroll
                    for (int n = 0; n < 2; ++n) { GB* p = rp + bj * 128 + 16 * n;
                        const f32x4 res = f32src ? *(const Gf32x4*)(sp + bj * 128 + 16 * n) : ld4bf(p);
                        st4bf(p, res * DN_ALPHA + gv[bj][n] * acc[ai][bj][m][n]);
                    } }
    }
};
struct EpiGU {
    GB* HB;
    __device__ __forceinline__ void operator()(AccRef acc, const Unit& u, int wr, int wc, int fr, int fq) const {
        const int row0 = u.pm * 256 + wr * 64 + fr, col0 = u.pn * 128 + wc * 32 + 4 * fq;
#pragma unroll
        for (int ai = 0; ai < 2; ++ai)
#pragma unroll
            for (int m = 0; m < 4; ++m) { GB* rp = HB + (size_t)(row0 + ai * 128 + m * 16) * 512 + col0;
#pragma unroll
                for (int n = 0; n < 2; ++n) { const f32x4 gt = acc[ai][0][m][n], up = acc[ai][1][m][n]; f32x4 h;
#pragma unroll
                    for (int j = 0; j < 4; ++j) h[j] = gt[j] * __builtin_amdgcn_rcpf(1.f + __builtin_amdgcn_exp2f(-LOG2E * gt[j])) * up[j];
                    st4bf(rp + 16 * n, h); } }
    }
};


struct RouterP {
    const GB *VH, *VL, *WH, *WL; int K, lda, ldb; static constexpr int kstepB = 128;
    __device__ __forceinline__ const GAS char* aptr(const Unit& u) const { const int part = u.pn >> 1, half = u.pn & 1; return (const GAS char*)((part == 1 ? VL : VH) + (size_t)u.pm * 256 * 2048 + half * 1024); }
    __device__ __forceinline__ const GAS char* bptr(const Unit& u) const { const int part = u.pn >> 1, half = u.pn & 1; return (const GAS char*)((part == 2 ? WL : WH) + half * 1024); }
};
struct SliceOrder { int nM, G, c; __device__ bool next(int i, Unit& u) const { const int L = i * G + c; if (L >= nM * 6) return false; u.pm = L / 6; u.pn = L % 6; u.ex = 0; return true; } };
struct EpiRouter {
    GF* RP;
    __device__ __forceinline__ void operator()(AccRef acc, const Unit& u, int wr, int wc, int fr, int fq) const {
        if (wc >= 3) return;
        const int row0 = u.pm * 256 + wr * 64 + fr;
#pragma unroll
        for (int ai = 0; ai < 2; ++ai)
#pragma unroll
            for (int m = 0; m < 4; ++m) { GF* rp = RP + ((size_t)u.pn * T + row0 + ai * 128 + m * 16) * 80 + wc * 32 + 4 * fq;
#pragma unroll
                for (int n = 0; n < 2; ++n) if (wc * 32 + 16 * n + 4 * fq < 72) *(Gf32x4*)(rp + 16 * n) = acc[ai][0][m][n]; }
    }
};

namespace mg {
constexpr int A_OFF = 0, A_BUF = 49152, B_OFF = 98304, B_BUF = 16384;
__device__ __forceinline__ int swz(int row, int ch) { return row * 128 + ((ch ^ (row & 7)) << 4); }
__device__ __forceinline__ int swzb(int row, int ch) { return row * 128 + ((ch ^ ((((row >> 1) ^ (row >> 4)) & 1) | (((row >> 2) & 3) << 1))) << 4); }
constexpr int TAB_OFF = 135168;
template <int MODE>
__device__ __forceinline__ void moe_gemm(LAS unsigned char* lds, const GB* A, const GF* Wl, GB* O, const GI* ts, const GI* tv, const GI* s2t, int nst, int G, int c) {
    constexpr int K = MODE == 0 ? 2048 : 512, LDW = MODE == 0 ? 1024 : 2048, LDA = K, NPT = MODE == 0 ? 8 : 16, NKT = K / 64;
    int tid_ = threadIdx.x; asm volatile("" : "+v"(tid_));
    const int tid = tid_, wid = __builtin_amdgcn_readfirstlane(tid >> 6), lane = tid & 63, fr = lane & 15, fq = lane >> 4;
    LAS int* tab = (LAS int*)(lds + TAB_OFF);
    if (tid < 128) { const bool in = tid < nst; tab[tid] = in ? __hip_atomic_load(ts + tid, __ATOMIC_RELAXED, __HIP_MEMORY_SCOPE_AGENT) : 0;
        tab[128 + tid] = in ? __hip_atomic_load(tv + tid, __ATOMIC_RELAXED, __HIP_MEMORY_SCOPE_AGENT) : 0; }
    __syncthreads();
    const int tpr = G / NPT;
    int tl, pt;
    if ((G & 7) == 0 && (tpr & 7) == 0) { const int x = c & 7, sl = c >> 3; tl = x * (tpr >> 3) + sl / NPT; pt = sl % NPT; } else { tl = c / NPT; pt = c % NPT; if (tl >= tpr) tl = nst; }
    const int n4 = tid & 31, k4 = tid >> 5;
    const int nb = 4 * n4, bcol = MODE == 0 ? (nb < 64 ? 64 * pt + nb : 512 + 64 * pt + (nb - 64)) : 128 * pt + nb;
    if (tl < nst) {
        int st = tl, e = __builtin_amdgcn_readfirstlane(tab[st]), tvc = __builtin_amdgcn_readfirstlane(tab[128 + st]), ngrp = (tvc + 63) >> 6;
        const GF* W = Wl + (size_t)e * K * LDW; const GB* Ab = A + (size_t)st * 512 * LDA;
        f32x4 acc[3][8];
#pragma unroll
        for (int m = 0; m < 3; ++m)
#pragma unroll
            for (int n = 0; n < 8; ++n) acc[m][n] = (f32x4){0.f, 0.f, 0.f, 0.f};
        f32x4 pb0[4], pb1[4];
#pragma unroll
        for (int q = 0; q < 4; ++q) { pb0[q] = (f32x4){0.f, 0.f, 0.f, 0.f}; pb1[q] = (f32x4){0.f, 0.f, 0.f, 0.f}; }
        unsigned voa = (unsigned)((tid >> 3) * LDA + 8 * ((tid & 7) ^ ((tid >> 3) & 7))) * 2u, vob = (unsigned)(4 * k4 * LDW + bcol) * 4u;
        asm volatile("" : "+v"(voa), "+v"(vob));
        const unsigned ldsw = (unsigned)wid * 1024u;
        const unsigned choff = 16u * (unsigned)((tid & 7) ^ ((tid >> 3) & 7)); unsigned vot = (unsigned)(tid >> 3) * 4u; asm volatile("" : "+v"(vot));
        unsigned voa6[6] = {0u, 0u, 0u, 0u, 0u, 0u}, voa6n[6] = {0u, 0u, 0u, 0u, 0u, 0u};
#define MG_LDT(dst6, stX) do { _Pragma("unroll") for (int i = 0; i < 6; ++i) asm volatile("global_load_dword %0, %1, %2" : "+v"(dst6[i]) : "v"(vot + (unsigned)(i * 256)), "s"((const GAS char*)(s2t + (size_t)(stX) * 512)) : "memory"); } while (0)
#define MG_TOK(dst6, tvX) do { _Pragma("unroll") for (int i = 0; i < 6; ++i) dst6[i] = ((tid >> 3) + 64 * i < (tvX) ? dst6[i] : 0u) * 4096u + choff; } while (0)
#define MG_LDA0(cb, VO, ng_, kt) do { _Pragma("unroll") for (int i = 0; i < 6; ++i) \
            __builtin_amdgcn_global_load_lds((const unsigned*)((const GAS char*)(A + (kt) * 64) + VO[i]), (LAS unsigned*)(lds + A_OFF + (cb) * A_BUF + i * 8192 + ldsw), 16, 0, 0); } while (0)
#define MG_GLD(dst, voff, base) asm volatile("global_load_dwordx4 %0, %1, %2" : "+v"(dst) : "v"(voff), "s"(base) : "memory")
#define MG_LDA(cb, Ab_, ng_, kt) do { _Pragma("unroll") for (int i = 0; i < 6; ++i) \
            __builtin_amdgcn_global_load_lds((const unsigned*)((const GAS char*)((Ab_) + (size_t)(i < (ng_) ? i : 0) * 64 * LDA + (kt) * 64) + voa), (LAS unsigned*)(lds + A_OFF + (cb) * A_BUF + i * 8192 + ldsw), 16, 0, 0); } while (0)
#define MG_LDB(W_, kt, P) do { _Pragma("unroll") for (int q = 0; q < 4; ++q) MG_GLD(P[q], vob, (const GAS char*)((W_) + (size_t)((kt) * 64 + q) * LDW)); } while (0)
#define MG_WAIT(P, N) asm volatile("s_waitcnt vmcnt(" #N ")" : "+v"(P[0]), "+v"(P[1]), "+v"(P[2]), "+v"(P[3]) :: "memory")
#define MG_ITER(cb, P, NW, LOADS) do { \
            MG_WAIT(P, NW); \
            _Pragma("unroll") for (int j = 0; j < 4; ++j) { u32x2 w; w.x = cvt_pk_bf16(P[0][j], P[1][j]); w.y = cvt_pk_bf16(P[2][j], P[3][j]); \
                *(LAS u32x2*)(lds + B_OFF + cb * B_BUF + swzb(nb + j, k4 >> 1) + (k4 & 1) * 8) = w; } \
            asm volatile("s_waitcnt lgkmcnt(0)" ::: "memory"); __builtin_amdgcn_s_barrier();     \
            LOADS;                                                       \
            _Pragma("unroll") for (int ks = 0; ks < 2; ++ks) { \
                bf16x8 Af[3]; \
                _Pragma("unroll") for (int m = 0; m < 3; ++m) Af[m] = *(const LAS bf16x8*)(lds + A_OFF + cb * A_BUF + swz(wid * 48 + m * 16 + fr, ks * 4 + fq)); \
                _Pragma("unroll") for (int nh = 0; nh < 4; ++nh) { \
                    bf16x8 Bf[2]; \
                    _Pragma("unroll") for (int n = 0; n < 2; ++n) Bf[n] = *(const LAS bf16x8*)(lds + B_OFF + cb * B_BUF + swzb((nh * 2 + n) * 16 + fr, ks * 4 + fq)); \
                    _Pragma("unroll") for (int m = 0; m < 3; ++m) \
                        _Pragma("unroll") for (int n = 0; n < 2; ++n) acc[m][nh * 2 + n] = __builtin_amdgcn_mfma_f32_16x16x32_bf16(Bf[n], Af[m], acc[m][nh * 2 + n], 0, 0, 0); \
                } \
            } } while (0)
        if constexpr (MODE == 0) {
            MG_LDT(voa6, st); asm volatile("s_waitcnt vmcnt(0)" : "+v"(voa6[0]), "+v"(voa6[1]), "+v"(voa6[2]), "+v"(voa6[3]), "+v"(voa6[4]), "+v"(voa6[5]) :: "memory"); MG_TOK(voa6, tvc);
            MG_LDB(W, 0, pb0); MG_LDA0(0, voa6, ngrp, 0); MG_LDB(W, 1, pb1);
        } else { MG_LDB(W, 0, pb0); MG_LDA(0, Ab, ngrp, 0); MG_LDB(W, 1, pb1); }
        for (;;) {
            const int stn = st + tpr; const bool more = stn < nst; const int sn = more ? stn : st;
            const int en = __builtin_amdgcn_readfirstlane(tab[sn]), tvn = __builtin_amdgcn_readfirstlane(tab[128 + sn]), ngn = (tvn + 63) >> 6;
            const GF* Wn = Wl + (size_t)en * K * LDW; const GB* Abn = A + (size_t)sn * 512 * LDA;
            if constexpr (MODE == 0) {
                MG_LDT(voa6n, sn);
                { const GF* Wa = W + (size_t)2 * 64 * LDW;
                  MG_ITER(0, pb0, 10, MG_LDA0(1, voa6, ngrp, 1); MG_LDB(Wa, 0, pb0));
                  MG_ITER(1, pb1, 4, MG_LDA0(0, voa6, ngrp, 2); MG_LDB(Wa, 1, pb1)); }
                asm volatile("" : "+v"(voa6n[0]), "+v"(voa6n[1]), "+v"(voa6n[2]), "+v"(voa6n[3]), "+v"(voa6n[4]), "+v"(voa6n[5]));
                MG_TOK(voa6n, tvn);
                for (int kt = 2; kt < NKT - 2; kt += 2) {
                    const GF* Wa = W + (size_t)(kt + 2) * 64 * LDW;
                    MG_ITER(0, pb0, 4, MG_LDA0(1, voa6, ngrp, kt + 1); MG_LDB(Wa, 0, pb0));
                    MG_ITER(1, pb1, 4, MG_LDA0(0, voa6, ngrp, kt + 2); MG_LDB(Wa, 1, pb1));
                }
                MG_ITER(0, pb0, 4, MG_LDA0(1, voa6, ngrp, NKT - 1); MG_LDB(Wn, 0, pb0));
                MG_ITER(1, pb1, 4, MG_LDA0(0, voa6n, ngn, 0); MG_LDB(Wn, 1, pb1));
            } else {
                for (int kt = 0; kt < NKT; kt += 2) {
                    const bool tail = kt + 2 >= NKT;
                    const GF* Wa = tail ? Wn : W + (size_t)(kt + 2) * 64 * LDW; const GB* Aa = tail ? Abn : Ab + (kt + 2) * 64; const int nga = tail ? ngn : ngrp;
                    MG_ITER(0, pb0, 4, MG_LDA(1, Ab, ngrp, kt + 1); MG_LDB(Wa, 0, pb0));
                    MG_ITER(1, pb1, 4, MG_LDA(0, Aa, nga, 0); MG_LDB(Wa, 1, pb1));
                }
            }
            const int row0 = st * 512 + wid * 48 + fr;
            if (MODE == 0) {
#pragma unroll
                for (int m = 0; m < 3; ++m)
#pragma unroll
                    for (int n = 0; n < 4; ++n) { const f32x4 gt = acc[m][n], up = acc[m][n + 4]; f32x4 h;
#pragma unroll
                        for (int j = 0; j < 4; ++j) h[j] = gt[j] * __builtin_amdgcn_rcpf(1.f + __builtin_amdgcn_exp2f(-LOG2E * gt[j])) * up[j];
                        st4bf(O + (size_t)(row0 + m * 16) * 512 + 64 * pt + 16 * n + 4 * fq, h); }
            } else {
#pragma unroll
                for (int m = 0; m < 3; ++m)
#pragma unroll
                    for (int n = 0; n < 8; ++n) st4bf(O + (size_t)(row0 + m * 16) * 2048 + 128 * pt + 16 * n + 4 * fq, acc[m][n]);
            }
            if (!more) break;
#pragma unroll
            for (int m = 0; m < 3; ++m)
#pragma unroll
                for (int n = 0; n < 8; ++n) acc[m][n] = (f32x4){0.f, 0.f, 0.f, 0.f};
            st = stn; W = Wn; Ab = Abn; ngrp = ngn;
#pragma unroll
            for (int i = 0; i < 6; ++i) voa6[i] = voa6n[i];
        }
        asm volatile("s_waitcnt vmcnt(0)" : "+v"(pb0[0]), "+v"(pb0[1]), "+v"(pb0[2]), "+v"(pb0[3]), "+v"(pb1[0]), "+v"(pb1[1]), "+v"(pb1[2]), "+v"(pb1[3]) :: "memory");
#undef MG_ITER
#undef MG_LDA0
#undef MG_TOK
#undef MG_LDT
#undef MG_WAIT
#undef MG_LDB
#undef MG_LDA
#undef MG_GLD
    }
    __syncthreads();
}
}

namespace att {
constexpr int KVBLK = 64;
constexpr int SHM_V = KVBLK * 128 * 2, SHM_K = KVBLK * 128 * 2, SHM_R = KVBLK * 64 * 2;
constexpr int OFF_V = 0, OFF_K = 2 * SHM_V, OFF_R = OFF_K + 2 * SHM_K, OFF_WS = OFF_R + 2 * SHM_R, ATT_LDS = OFF_WS + 8 * 64 * 4;
constexpr float THR2 = 8.f * LOG2E;
#define KSWZ(row, colB) ((row) * 256 + ((colB) ^ ((((row) & 7) | ((((row) >> 4) & 1) << 3)) << 4)))
#define SBAR() __builtin_amdgcn_sched_barrier(0)
__device__ __forceinline__ int crow(int r, int hi) { return (r & 3) + 8 * (r >> 2) + 4 * hi; }
__device__ __forceinline__ void partialSM(f32x16& p0, f32x16& p1, float& m_reg, float& alpha) {
    float pmax = p0[0];
#pragma unroll
    for (int r = 1; r < 16; ++r) pmax = fmaxf(pmax, p0[r]);
#pragma unroll
    for (int r = 0; r < 16; ++r) pmax = fmaxf(pmax, p1[r]);
    { auto rr = __builtin_amdgcn_permlane32_swap(__float_as_uint(pmax), __float_as_uint(pmax), false, false); pmax = fmaxf(__uint_as_float(rr[0]), __uint_as_float(rr[1])); }
    float mn;
    if (__builtin_expect(__all(pmax - m_reg <= THR2), 1)) { mn = m_reg; alpha = 1.f; }
    else { mn = fmaxf(m_reg, pmax); alpha = __builtin_amdgcn_exp2f(m_reg - mn); m_reg = mn; }
#pragma unroll
    for (int r = 0; r < 16; ++r) p0[r] = p0[r] - mn;
#pragma unroll
    for (int r = 0; r < 16; ++r) p1[r] = p1[r] - mn;
#pragma unroll
    for (int r = 0; r < 16; ++r) p0[r] = __builtin_amdgcn_exp2f(p0[r]);
}
__device__ __forceinline__ void finishSM(f32x16& p0, f32x16& p1, float alpha, float& l_reg, bf16x8& pa0, bf16x8& pa1, bf16x8& pa2, bf16x8& pa3) {
#pragma unroll
    for (int r = 0; r < 16; ++r) p1[r] = __builtin_amdgcn_exp2f(p1[r]);
    float ps = 0;
#pragma unroll
    for (int r = 0; r < 16; ++r) ps += p0[r];
#pragma unroll
    for (int r = 0; r < 16; ++r) ps += p1[r];
    { auto rr = __builtin_amdgcn_permlane32_swap(__float_as_uint(ps), __float_as_uint(ps), false, false); ps = __uint_as_float(rr[0]) + __uint_as_float(rr[1]); }
    l_reg = l_reg * alpha + ps;
#define PK4(P, BASE, OUT) do { unsigned a0 = cvt_pk_bf16(P[BASE + 0], P[BASE + 1]), a1 = cvt_pk_bf16(P[BASE + 2], P[BASE + 3]);   \
    unsigned b0 = cvt_pk_bf16(P[BASE + 4], P[BASE + 5]), b1 = cvt_pk_bf16(P[BASE + 6], P[BASE + 7]);                              \
    auto r0 = __builtin_amdgcn_permlane32_swap(a0, b0, false, false); auto r1 = __builtin_amdgcn_permlane32_swap(a1, b1, false, false); \
    u32x4 w = {r0[0], r1[0], r0[1], r1[1]}; OUT = __builtin_bit_cast(bf16x8, w); } while (0)
    PK4(p0, 0, pa0); PK4(p0, 8, pa1); PK4(p1, 0, pa2); PK4(p1, 8, pa3);
#undef PK4
}
__device__ __forceinline__ int v_st(int k, int c) { const int kk = (k & ~0xC) | ((k & 4) << 1) | ((k & 8) >> 1); return ((kk >> 3) * 4 + (c >> 5)) * 512 + ((kk & 7) * 32 + (c & 31)) * 2; }
__device__ __forceinline__ int v_rd_base(int lane) { return ((lane & 3) << 3) | (((lane >> 2) & 3) << 6) | (((lane >> 4) & 1) << 5) | (((lane >> 5) & 1) << 8); }
constexpr int v_rd_off(int d0, int ks, int half) { return d0 * 512 + ks * 4096 + half * 2048; }
template <int OFF> __device__ __forceinline__ s16x4 tr_read(unsigned vb) { s16x4 r; asm volatile("ds_read_b64_tr_b16 %0, %1 offset:%2" : "=&v"(r) : "v"(vb), "i"(OFF) : "memory"); return r; }
template <int D0> __device__ __forceinline__ void pv_one(f32x16& od, unsigned vb, bf16x8 pa0, bf16x8 pa1, bf16x8 pa2, bf16x8 pa3) {
    const s16x4 l0 = tr_read<v_rd_off(D0, 0, 0)>(vb), h0 = tr_read<v_rd_off(D0, 0, 1)>(vb), l1 = tr_read<v_rd_off(D0, 1, 0)>(vb), h1 = tr_read<v_rd_off(D0, 1, 1)>(vb);
    const s16x4 l2 = tr_read<v_rd_off(D0, 2, 0)>(vb), h2 = tr_read<v_rd_off(D0, 2, 1)>(vb), l3 = tr_read<v_rd_off(D0, 3, 0)>(vb), h3 = tr_read<v_rd_off(D0, 3, 1)>(vb);
    asm volatile("s_waitcnt lgkmcnt(0)" ::: "memory"); SBAR();
#define PK(L, H) (bf16x8){L[0], L[1], L[2], L[3], H[0], H[1], H[2], H[3]}
    od = __builtin_amdgcn_mfma_f32_32x32x16_bf16(pa0, PK(l0, h0), od, 0, 0, 0);
    od = __builtin_amdgcn_mfma_f32_32x32x16_bf16(pa1, PK(l1, h1), od, 0, 0, 0);
    od = __builtin_amdgcn_mfma_f32_32x32x16_bf16(pa2, PK(l2, h2), od, 0, 0, 0);
    od = __builtin_amdgcn_mfma_f32_32x32x16_bf16(pa3, PK(l3, h3), od, 0, 0, 0);
#undef PK
}
__device__ __forceinline__ void pv_d0(f32x16* o, unsigned vb, bf16x8 pa0, bf16x8 pa1, bf16x8 pa2, bf16x8 pa3) {
    pv_one<0>(o[0], vb, pa0, pa1, pa2, pa3); pv_one<1>(o[1], vb, pa0, pa1, pa2, pa3); pv_one<2>(o[2], vb, pa0, pa1, pa2, pa3); pv_one<3>(o[3], vb, pa0, pa1, pa2, pa3);
}

struct Args {
    const GB*Q, *K, *V, *KR; GB* O;
    int ldq, ldk, ldo, qcol, kcol, ocol;
    int qrow0;
    int nt_ctx, nt, ctx_row0, lat_row0;
    float lamv, osc; const GF* gsub;
};

template <int MODE>
__device__ __forceinline__ void attn_unit(const Args& a, LAS unsigned char* lds) {
    constexpr int NKS = MODE == 0 ? 12 : 4;
    int tid_ = threadIdx.x; asm volatile("" : "+v"(tid_));
    const int tid = tid_, wid = __builtin_amdgcn_readfirstlane(tid >> 6), lane = tid & 63, r32 = lane & 31, hi = lane >> 5;
    const int grp = MODE == 1 ? (wid >> 2) : 0, wq = MODE == 1 ? (wid & 3) : wid;
    LAS unsigned char* V_lds = lds + OFF_V; LAS unsigned char* K_lds = lds + OFF_K; LAS unsigned char* R_lds = lds + OFF_R;
    LAS float* ws = (LAS float*)(lds + OFF_WS) + wid * 64; LAS float* li_l = ws; LAS float* al_l = ws + 32;
    float m_reg = -1e30f, l_reg = 0; f32x16 o[4] = {}; bf16x8 qr[NKS];
    {
        const GB* Qw = a.Q + (size_t)(a.qrow0 + wq * 32 + r32) * a.ldq + a.qcol + (MODE == 1 ? grp * 64 : 0) + hi * 8;
#pragma unroll
        for (int d0 = 0; d0 < NKS; ++d0) qr[d0] = *(const Gbf16x8*)(Qw + d0 * 16);
    }
    const int sr = tid >> 4, sc = (tid & 15) * 8, vst0 = v_st(sr, sc), vst1 = v_st(32 + sr, sc);
    const int rr = tid >> 3, rc = (tid & 7) * 8, rst = KSWZ(rr & 31, ((rr >> 5) * 64 + rc) * 2);
    const unsigned vb0 = (unsigned)(size_t)V_lds + v_rd_base(lane);
    const GB* Kg = a.K + a.kcol + sc; const GB* Vg = a.V + a.kcol + sc; const GB* Rg = a.KR + rc;
    bf16x8 svs0, svs1, sks0, sks1, skr;
#define KROW(j) ((j) < a.nt_ctx ? a.ctx_row0 + 64 * (j) : a.lat_row0 + 64 * ((j) - a.nt_ctx))
#define SLOAD(j) do { const int k0_ = KROW(j); svs0 = *(const Gbf16x8*)(Vg + (size_t)(k0_ + sr) * a.ldk); svs1 = *(const Gbf16x8*)(Vg + (size_t)(k0_ + 32 + sr) * a.ldk); \
    sks0 = *(const Gbf16x8*)(Kg + (size_t)(k0_ + sr) * a.ldk); sks1 = *(const Gbf16x8*)(Kg + (size_t)(k0_ + 32 + sr) * a.ldk); \
    if (MODE == 0) skr = *(const Gbf16x8*)(Rg + (size_t)(k0_ + rr) * 64); } while (0)
#define SWRITE(b) do { *(LAS bf16x8*)(V_lds + (b) * SHM_V + vst0) = svs0; *(LAS bf16x8*)(V_lds + (b) * SHM_V + vst1) = svs1; const int kc = sc * 2; \
    *(LAS bf16x8*)(K_lds + (b) * SHM_K + KSWZ(sr, kc)) = sks0; *(LAS bf16x8*)(K_lds + (b) * SHM_K + KSWZ(32 + sr, kc)) = sks1; \
    if (MODE == 0) *(LAS bf16x8*)(R_lds + (b) * SHM_R + rst) = skr; } while (0)
#define RESC(al) do { if (__any((al) < 1.f)) { if (hi == 0) al_l[r32] = (al); asm volatile("s_waitcnt lgkmcnt(0)" ::: "memory"); \
    _Pragma("unroll") for (int d = 0; d < 4; ++d) _Pragma("unroll") for (int r = 0; r < 16; ++r) o[d][r] *= al_l[crow(r, hi)]; } } while (0)
#define QKT(P0, P1, b) do { P0 = f32x16{}; P1 = f32x16{}; \
    if (MODE == 0) { \
        _Pragma("unroll") for (int d0 = 0; d0 < 8; ++d0) { const int cb = (d0 * 16 + hi * 8) * 2; \
            const bf16x8 b0 = *(const LAS bf16x8*)(K_lds + (b) * SHM_K + KSWZ(r32, cb)), b1 = *(const LAS bf16x8*)(K_lds + (b) * SHM_K + KSWZ(32 + r32, cb)); \
            P0 = __builtin_amdgcn_mfma_f32_32x32x16_bf16(b0, qr[d0], P0, 0, 0, 0); P1 = __builtin_amdgcn_mfma_f32_32x32x16_bf16(b1, qr[d0], P1, 0, 0, 0); } \
        _Pragma("unroll") for (int d0 = 0; d0 < 4; ++d0) { const int cb = (d0 * 16 + hi * 8) * 2; \
            const bf16x8 b0 = *(const LAS bf16x8*)(R_lds + (b) * SHM_R + KSWZ(r32, cb)), b1 = *(const LAS bf16x8*)(R_lds + (b) * SHM_R + KSWZ(r32, 128 + cb)); \
            P0 = __builtin_amdgcn_mfma_f32_32x32x16_bf16(b0, qr[8 + d0 < NKS ? 8 + d0 : 0], P0, 0, 0, 0); P1 = __builtin_amdgcn_mfma_f32_32x32x16_bf16(b1, qr[8 + d0 < NKS ? 8 + d0 : 0], P1, 0, 0, 0); } \
    } else { \
        _Pragma("unroll") for (int d0 = 0; d0 < 4; ++d0) { const int cb = (grp * 64 + d0 * 16 + hi * 8) * 2; \
            const bf16x8 b0 = *(const LAS bf16x8*)(K_lds + (b) * SHM_K + KSWZ(r32, cb)), b1 = *(const LAS bf16x8*)(K_lds + (b) * SHM_K + KSWZ(32 + r32, cb)); \
            P0 = __builtin_amdgcn_mfma_f32_32x32x16_bf16(b0, qr[d0], P0, 0, 0, 0); P1 = __builtin_amdgcn_mfma_f32_32x32x16_bf16(b1, qr[d0], P1, 0, 0, 0); } \
    } } while (0)
    f32x16 p0, p1; float al; bf16x8 pa0, pa1, pa2, pa3; const int NT = a.nt;
    SLOAD(0); asm volatile("s_waitcnt vmcnt(0)" ::: "memory"); SWRITE(0); __syncthreads();
    for (int j = 0; j < NT; ++j) {
        const int cur = j & 1; const bool more = j + 1 < NT;
        if (more) SLOAD(j + 1);
        SBAR(); QKT(p0, p1, cur);
        partialSM(p0, p1, m_reg, al);
        finishSM(p0, p1, al, l_reg, pa0, pa1, pa2, pa3); SBAR();
        RESC(al);
        pv_d0(o, vb0 + cur * SHM_V, pa0, pa1, pa2, pa3);
        if (more) { asm volatile("s_waitcnt vmcnt(0)" ::: "memory"); SWRITE(cur ^ 1); }
        __syncthreads();
    }
    if (hi == 0) li_l[r32] = l_reg; asm volatile("s_waitcnt lgkmcnt(0)" ::: "memory");
    float rli[16];
#pragma unroll
    for (int r = 0; r < 16; ++r) rli[r] = __builtin_amdgcn_rcpf(li_l[crow(r, hi)]);
    if (MODE == 0) {
        GB* Ow = a.O + (size_t)(a.qrow0 + wq * 32) * a.ldo + a.ocol;
#pragma unroll
        for (int r = 0; r < 16; ++r) { const int orow = crow(r, hi);
#pragma unroll
            for (int d0 = 0; d0 < 4; ++d0) Ow[(size_t)orow * a.ldo + d0 * 32 + r32] = (bf16_t)f2bf(o[d0][r] * rli[r]); }
        __syncthreads();
    } else {
        __syncthreads();
        LAS float* stash = (LAS float*)lds;
        if (grp == 1) {
#pragma unroll
            for (int d0 = 0; d0 < 4; ++d0)
#pragma unroll
                for (int r = 0; r < 16; ++r) stash[((wq * 4 + d0) * 16 + r) * 64 + lane] = o[d0][r] * rli[r];
        }
        __syncthreads();
        if (grp == 0) {
            float ss[16];
#pragma unroll
            for (int r = 0; r < 16; ++r) { ss[r] = 0.f;
#pragma unroll
                for (int d0 = 0; d0 < 4; ++d0) { const float x = o[d0][r] * rli[r] - a.lamv * stash[((wq * 4 + d0) * 16 + r) * 64 + lane]; o[d0][r] = x; ss[r] += x * x; } }
#pragma unroll
            for (int r = 0; r < 16; ++r) {
#pragma unroll
                for (int of = 1; of < 32; of <<= 1) ss[r] += __shfl_xor(ss[r], of);
                ss[r] = a.osc / sqrtf(ss[r] * (1.f / 128.f) + EPS); }
            float gs[4];
#pragma unroll
            for (int d0 = 0; d0 < 4; ++d0) gs[d0] = a.gsub[d0 * 32 + r32];
            GB* Ow = a.O + (size_t)(a.qrow0 + wq * 32) * a.ldo + a.ocol;
#pragma unroll
            for (int r = 0; r < 16; ++r) { const int orow = crow(r, hi);
#pragma unroll
                for (int d0 = 0; d0 < 4; ++d0) Ow[(size_t)orow * a.ldo + d0 * 32 + r32] = (bf16_t)f2bf(o[d0][r] * ss[r] * gs[d0]); }
        }
        __syncthreads();
    }
#undef KROW
#undef SLOAD
#undef SWRITE
#undef RESC
#undef QKT
}
}

#define XB_TMO      128
#define XB_XCNT(j)  (256  + 64 * (j))
#define XB_XSUB(j)  (1280 + 64 * (j))
#define XB_XGEN(j)  (2304 + 64 * (j))
#define XB_TOP      3328
#define XB_TOPGEN   3392
#define XCD_BAR_WORDS 3456
#define XB_SPIN_CAP (1u << 22)
__device__ __forceinline__ unsigned xb_ld(unsigned* p)              { return __hip_atomic_load(p, __ATOMIC_RELAXED, __HIP_MEMORY_SCOPE_AGENT); }
__device__ __forceinline__ unsigned xb_add(unsigned* p, unsigned v) { return __hip_atomic_fetch_add(p, v, __ATOMIC_RELAXED, __HIP_MEMORY_SCOPE_AGENT); }
__device__ __forceinline__ unsigned xb_xcc_id() { return (unsigned)__builtin_amdgcn_s_getreg((3 << 11) | 20) & 0xFu; }
#define XB_SPIN(cond, bar) do { unsigned _sp = 0; while (cond) { __builtin_amdgcn_s_sleep(1); \
    if ((++_sp & 255u) == 0u) { if (xb_ld(&(bar)[XB_TMO])) break; if (_sp > XB_SPIN_CAP) { atomicAdd(&(bar)[XB_TMO], 1u); break; } } } } while (0)
struct XcdBarrier { unsigned* bar; unsigned x; volatile LAS unsigned* st; };
__device__ __forceinline__ XcdBarrier xcd_barrier_post(unsigned* bar, volatile LAS unsigned* st) {
    XcdBarrier b; b.bar = bar; b.x = xb_xcc_id(); b.st = st;
    if (threadIdx.x == 0) (void)xb_add(&bar[XB_XCNT(b.x)], 1u);
    return b;
}
__device__ __forceinline__ void xcd_barrier_complete(unsigned* bar, unsigned x, unsigned& nloc, unsigned& nx) {
    const unsigned G = gridDim.x * gridDim.y * gridDim.z;
    unsigned sum, cnt, mine, sp = 0u;
    for (;;) {
        sum = 0u; cnt = 0u; mine = 0u;
#pragma unroll
        for (unsigned j = 0; j < 16; ++j) { const unsigned c = xb_ld(&bar[XB_XCNT(j)]); sum += c; cnt += (c > 0u) ? 1u : 0u; mine = (j == x) ? c : mine; }
        if (sum == G) break;
        __builtin_amdgcn_s_sleep(1);
        if ((++sp & 255u) == 0u) { if (xb_ld(&bar[XB_TMO])) break; if (sp > XB_SPIN_CAP) { atomicAdd(&bar[XB_TMO], 1u); break; } }
    }
    nloc = mine > 0u ? mine : 1u; nx = cnt > 0u ? cnt : 1u;
}
__device__ __forceinline__ void xcd_barrier(const XcdBarrier& b) {
    asm volatile("s_waitcnt vmcnt(0)" ::: "memory");
    __syncthreads();
    if (threadIdx.x == 0) {
        unsigned* bar = b.bar;
        __builtin_amdgcn_s_waitcnt(0);
        unsigned nloc = b.st[0], nx = b.st[1];
        if (nloc == 0u) { xcd_barrier_complete(bar, b.x, nloc, nx); b.st[0] = nloc; b.st[1] = nx; }
        const unsigned old = xb_add(&bar[XB_XSUB(b.x)], 1u);
        const unsigned gen = old / nloc;
        if (old + 1u == (gen + 1u) * nloc) {
            __builtin_amdgcn_fence(__ATOMIC_RELEASE, "agent");
            asm volatile("s_waitcnt vmcnt(0)" ::: "memory");
            const unsigned og = xb_add(&bar[XB_TOP], 1u);
            const unsigned tg = og / nx;
            if (og + 1u == (tg + 1u) * nx) xb_add(&bar[XB_TOPGEN], 1u);
            else XB_SPIN(xb_ld(&bar[XB_TOPGEN]) == tg, bar);
            __builtin_amdgcn_fence(__ATOMIC_ACQUIRE, "agent");
            xb_add(&bar[XB_XGEN(b.x)], 1u);
            asm volatile("s_waitcnt vmcnt(0)" ::: "memory");
        } else {
            XB_SPIN(xb_ld(&bar[XB_XGEN(b.x)]) == gen, bar);
            __builtin_amdgcn_fence(__ATOMIC_ACQUIRE, "agent");
            asm volatile("s_waitcnt vmcnt(0)" ::: "memory");
        }
    }
    __syncthreads();
}

constexpr int NWAVES = 8;
constexpr int RING_BYTES = 131072, LDSCTL_OFF = RING_BYTES, MISC_OFF = LDSCTL_OFF + 320, LDS_BYTES = 147456;
constexpr int NPHASE = 2 + 10 * NL;

struct Args {
    const float* in[30]; float* out; unsigned char* ws; int ph_lo, ph_hi, region, pad;
};

__device__ __forceinline__ void cvt_item(const GF* W, int ldw, int k0, int n0, GB* dst, int drow0, int ldd, const GF* sk, const GF* sn, float s, LAS float* scr, int lane) {
#pragma unroll 8
    for (int i = 0; i < 32; ++i) { const int kk = 2 * i + (lane >> 5); scr[kk * 33 + (lane & 31)] = W[(size_t)(k0 + kk) * ldw + n0 + (lane & 31)]; }
    asm volatile("s_waitcnt lgkmcnt(0)" ::: "memory");
    const int c = lane & 7;
    float skv[8];
#pragma unroll
    for (int q = 0; q < 8; ++q) skv[q] = sk ? sk[k0 + 8 * c + q] * s : s;
#pragma unroll
    for (int j = 0; j < 4; ++j) { const int n = (lane >> 3) + 8 * j; const LAS float* sp = scr + (8 * c) * 33 + n; const float f = sn ? sn[n0 + n] : 1.f;
        u32x4 o; o.x = pk2(sp[0 * 33] * skv[0] * f, sp[1 * 33] * skv[1] * f); o.y = pk2(sp[2 * 33] * skv[2] * f, sp[3 * 33] * skv[3] * f);
        o.z = pk2(sp[4 * 33] * skv[4] * f, sp[5 * 33] * skv[5] * f); o.w = pk2(sp[6 * 33] * skv[6] * f, sp[7 * 33] * skv[7] * f);
        *(Gu32x4*)(dst + (size_t)(drow0 + n) * ldd + k0 + 8 * c) = o; }
    asm volatile("s_waitcnt lgkmcnt(0)" ::: "memory");
}
__device__ __forceinline__ int win_dest_row(int n) {
    if (n < 512) return n;
    if (n < 576) return 1536 + (n - 512);
    if (n < 1088) return 512 + (n - 576);
    if (n < 1600) return 1024 + (n - 1088);
    if (n < 2368) return 1792 + (n - 1600);
    if (n < 2880) return 2560 + (n - 2368);
    if (n < 3392) return 3072 + (n - 2880);
    return 3584 + (n - 3392);
}

__global__ void __launch_bounds__(NWAVES * 64, 2) fwd(Args args) {
    extern __shared__ __attribute__((aligned(16))) unsigned char lds_raw[];
    LAS unsigned char* lds = (LAS unsigned char*)lds_raw;
    volatile LAS unsigned* MISC = (volatile LAS unsigned*)(lds + MISC_OFF);
    const int G = gridDim.x, bid = blockIdx.x, NGW = G * NWAVES;
#define PHASE_IDS() int tid_ = threadIdx.x; asm volatile("" : "+v"(tid_)); const int tid = tid_, lane = tid & 63, wave = __builtin_amdgcn_readfirstlane(tid >> 6), gw = bid * NWAVES + wave; (void)lane; (void)gw
    unsigned* ctl0 = (unsigned*)(args.ws + WS_CTL);
    for (int u = threadIdx.x; u < (LDS_BYTES - LDSCTL_OFF) / 4; u += NWAVES * 64) ((LAS unsigned*)(lds + LDSCTL_OFF))[u] = 0u;
    __syncthreads();
    XcdBarrier bar; bar.bar = ctl0 + CW_BAR + args.region * XCD_BAR_WORDS; bar.x = 0; bar.st = nullptr;
    const int lo = args.ph_lo, hi = args.ph_hi;
    const bool multi = (hi - lo) > 1;
    if (multi) bar = xcd_barrier_post(ctl0 + CW_BAR + args.region * XCD_BAR_WORDS, MISC + 8);
#ifdef ONLY
#define IN(k) ((((k) < 2 ? 100 + (k) : ((k) - 2) % 10) == ONLY) && lo <= (k) && (k) < hi)
#elif defined(EXCL)
#define IN(k) ((((k) < 2 ? 100 + (k) : ((k) - 2) % 10) != EXCL) && lo <= (k) && (k) < hi)
#else
#define IN(k) (lo <= (k) && (k) < hi)
#endif
#define SEAM(k) do { if (IN((k) + 1)) xcd_barrier(bar); } while (0)
#define SEAM_MID() do { if (multi) xcd_barrier(bar); } while (0)

#define PHASE_PTRS() CKA* kp = (CKA*)__builtin_amdgcn_kernarg_segment_ptr(); asm volatile("" : "+s"(kp)); GC* ws = (GC*)*(const unsigned long long __attribute__((address_space(4)))*)(kp + 248); GU* ctl = (GU*)(ws + WS_CTL); (void)ctl
#define INP(i) ((const GF*)*(const unsigned long long __attribute__((address_space(4)))*)(kp + 8 * (i)))
#define WSP(T, off) ((GAS T*)(ws + (off)))
    enum { I_X = 0, I_C, I_CTX, I_CCTX, I_WADA, I_BADA, I_WIN, I_BGATE, I_GQ, I_GKV, I_WUQ, I_WUKV, I_LAM, I_GSUB, I_WPOOL, I_PSCALE, I_WBM, I_WBD, I_WBP, I_WO, I_LN1G, I_LN1B, I_WGRP, I_BGRP, I_WEXP, I_BEXP, I_WGU, I_WDN, I_LN2G, I_LN2B };
    if (IN(0)) {
        PHASE_PTRS(); PHASE_IDS();
        const GF* c_in = INP(I_C); const GF* cctx_in = INP(I_CCTX); const GF* w_ada = INP(I_WADA); const GF* b_ada = INP(I_BADA);
        GF* MOD = WSP(float, WS_MOD); GF* ROPEC = WSP(float, WS_ROPE); GF* ROPES = ROPEC + 1024;
        {
            LAS float* sl = (LAS float*)lds;
            LAS float* red = sl + 5 * 2048;
            for (int i = tid; i < 5 * 2048; i += 512) { const float v = i < 4 * 2048 ? c_in[i] : cctx_in[i - 4 * 2048]; sl[i] = v / (1.f + __expf(-v)); }
            __syncthreads();
            const int c4 = tid & 7, kg = tid >> 3;
            for (int unit = bid; unit < NL * 384; unit += G) {
                const int l = unit / 384, c0 = (unit % 384) * 32;
                const GF* wp = w_ada + ((size_t)l * 2048 + kg) * 12288 + c0 + 4 * c4;
                f32x4 a0 = {0.f, 0.f, 0.f, 0.f}, a1 = a0, a2 = a0, a3 = a0, a4 = a0;
#pragma unroll 8
                for (int it = 0; it < 32; ++it) { const int k = kg + 64 * it; const f32x4 w = *(const Gf32x4*)(wp + (size_t)64 * it * 12288);
                    a0 += w * sl[k]; a1 += w * sl[2048 + k]; a2 += w * sl[4096 + k]; a3 += w * sl[6144 + k]; a4 += w * sl[8192 + k]; }
                *(LAS f32x4*)(red + (kg * 5 + 0) * 32 + 4 * c4) = a0; *(LAS f32x4*)(red + (kg * 5 + 1) * 32 + 4 * c4) = a1; *(LAS f32x4*)(red + (kg * 5 + 2) * 32 + 4 * c4) = a2;
                *(LAS f32x4*)(red + (kg * 5 + 3) * 32 + 4 * c4) = a3; *(LAS f32x4*)(red + (kg * 5 + 4) * 32 + 4 * c4) = a4;
                __syncthreads();
                if (tid < 160) { const int r = tid >> 5, col = tid & 31; float s = 0.f;
                    for (int q = 0; q < 64; ++q) s += red[(q * 5 + r) * 32 + col];
                    MOD[((size_t)l * 5 + r) * 12288 + c0 + col] = s + b_ada[(size_t)l * 12288 + c0 + col]; }
                __syncthreads();
            }
        }
        if (bid == 0 && tid < NL * 64) ctl[CW_CNT + tid] = 0u;
        if (bid == 0) for (int i = tid; i < 1024; i += 512) { const int pos = i >> 4, f = i & 15; const float inv = powf(10000.f, -(float)f / 16.f); const float ang = (float)pos * inv; ROPEC[i] = cosf(ang); ROPES[i] = sinf(ang); }
        for (int i = bid * 512 + tid; i < NL * 256 * 2048; i += G * 512) { const int l = i / (256 * 2048), r = i % (256 * 2048), cc = r / 2048, k = r % 2048;
            const float w = cc < 8 ? INP(I_WGRP)[((size_t)l * 2048 + k) * 8 + cc] : (cc < 72 ? INP(I_WEXP)[((size_t)l * 2048 + k) * 64 + (cc - 8)] : 0.f);
            const unsigned hi = f2bf(w); const float rem = w - __builtin_bit_cast(float, hi << 16);
            GB* wr = WSP(bf16_t, WS_WRT) + (size_t)l * 2 * 256 * 2048; wr[r] = (bf16_t)hi; wr[256 * 2048 + r] = (bf16_t)f2bf(rem); }
        for (int i = bid * 512 + tid; i < NL * 192 * 256; i += G * 512) { const int l = i / (192 * 256), r = i % (192 * 256); *(Gu32x4*)(WSP(bf16_t, WS_WIN) + ((size_t)l * NP + 1600) * 2048 + (size_t)r * 8) = (u32x4){0u, 0u, 0u, 0u}; }
        {
            LAS float* scr = (LAS float*)(lds + wave * 16384);
            constexpr int I_IN = 32 * 298, I_UKV = 8 * 64, I_UQ = 12 * 48, I_PL = 8 * 16, I_BM = 16 * 64, I_BD = 8 * 64, I_BP = 8 * 64, I_O = 32 * 64, I_GU = 0, I_DN = 0;
            constexpr int I_LAYER = I_IN + I_UKV + I_UQ + I_PL + I_BM + I_BD + I_BP + I_O + I_GU + I_DN;
            for (int it = gw; it < NL * I_LAYER; it += NGW) {
                const int l = it / I_LAYER; int r = it % I_LAYER;
                if (r < I_IN) { const int kb = r / 298, nb = r % 298, n0 = nb * 32; const float s = (n0 >= 2368 && n0 < 2880) ? 0.125f * LOG2E : 1.f;
                    cvt_item(INP(I_WIN) + (size_t)l * 2048 * IN_COLS, IN_COLS, kb * 64, n0, WSP(bf16_t, WS_WIN) + (size_t)l * NP * 2048, win_dest_row(n0) - 0, 2048, nullptr, nullptr, s, scr, lane); continue; } r -= I_IN;
                if (r < I_UKV) { const int kb = r / 64, nb = r % 64; cvt_item(INP(I_WUKV) + (size_t)l * 512 * 2048, 2048, kb * 64, nb * 32, WSP(bf16_t, WS_WUKV) + (size_t)l * 2048 * 512, nb * 32, 512, INP(I_GKV) + l * 512, nullptr, 1.f, scr, lane); continue; } r -= I_UKV;
                if (r < I_UQ) { const int kb = r / 48, nb = r % 48; cvt_item(INP(I_WUQ) + (size_t)l * 768 * 1536, 1536, kb * 64, nb * 32, WSP(bf16_t, WS_WUQ) + (size_t)l * 1536 * 768, nb * 32, 768, INP(I_GQ) + l * 768, nullptr, 0.07216878364870322f * LOG2E, scr, lane); continue; } r -= I_UQ;
                if (r < I_PL) { const int kb = r / 16, nb = r % 16, gk = kb >> 1, gn = nb >> 2;
                    if (gk == gn) cvt_item(INP(I_WPOOL) + ((size_t)l * 4 + gk) * 128 * 128, 128, (kb & 1) * 64, (nb & 3) * 32, WSP(bf16_t, WS_WPL) + (size_t)l * 512 * 512 + gk * 128, nb * 32, 512, nullptr, INP(I_PSCALE) + l * 512 + gn * 128, 1.f, scr, lane);
                    else { GB* dp = WSP(bf16_t, WS_WPL) + (size_t)l * 512 * 512 + (size_t)(nb * 32 + (lane >> 1)) * 512 + kb * 64 + (lane & 1) * 32;
#pragma unroll
                        for (int q = 0; q < 4; ++q) *(Gu32x4*)(dp + q * 8) = (u32x4){0u, 0u, 0u, 0u}; }
                    continue; } r -= I_PL;
                if (r < I_BM) { const int kb = r / 64, nb = r % 64; cvt_item(INP(I_WBM) + (size_t)l * 1024 * 2048, 2048, kb * 64, nb * 32, WSP(bf16_t, WS_WBM) + (size_t)l * 2048 * 1024, nb * 32, 1024, nullptr, nullptr, 1.f, scr, lane); continue; } r -= I_BM;
                if (r < I_BD) { const int kb = r / 64, nb = r % 64; cvt_item(INP(I_WBD) + (size_t)l * 512 * 2048, 2048, kb * 64, nb * 32, WSP(bf16_t, WS_WBD) + (size_t)l * 2048 * 512, nb * 32, 512, nullptr, nullptr, 1.f, scr, lane); continue; } r -= I_BD;
                if (r < I_BP) { const int kb = r / 64, nb = r % 64; cvt_item(INP(I_WBP) + (size_t)l * 512 * 2048, 2048, kb * 64, nb * 32, WSP(bf16_t, WS_WBP) + (size_t)l * 2048 * 512, nb * 32, 512, nullptr, nullptr, 1.f, scr, lane); continue; } r -= I_BP;
                if (r < I_O) { const int kb = r / 64, nb = r % 64; cvt_item(INP(I_WO) + (size_t)l * 2048 * 2048, 2048, kb * 64, nb * 32, WSP(bf16_t, WS_WO) + (size_t)l * 2048 * 2048, nb * 32, 2048, nullptr, nullptr, 1.f, scr, lane); continue; } r -= I_O;
            }
        }
        SEAM(0);
    }
    if (IN(1)) {
        PHASE_PTRS(); PHASE_IDS();
        const GF* x_in = INP(I_X); const GF* ctx_in = INP(I_CTX); const GF* MOD = WSP(float, WS_MOD); GB* U = WSP(bf16_t, WS_U);
        for (int pr = gw; pr < T / 2; pr += NGW) {
            const int row = 2 * pr;
            const GF* src = row < TL ? x_in + (size_t)row * 2048 : ctx_in + (size_t)(row - TL) * 2048; const int mrow = row < TL ? (row >> 11) : 4;
            const GF* md = MOD + (size_t)mrow * 12288;
            f32x4 v[2][8]; float sm[2] = {0.f, 0.f};
#pragma unroll
            for (int r = 0; r < 2; ++r)
#pragma unroll
                for (int j = 0; j < 8; ++j) v[r][j] = *(const Gf32x4*)(src + r * 2048 + 4 * lane + 256 * j);
#pragma unroll
            for (int r = 0; r < 2; ++r)
#pragma unroll
                for (int j = 0; j < 8; ++j) { sm[r] += (v[r][j][0] + v[r][j][1]) + (v[r][j][2] + v[r][j][3]); }
            float rstd[2];
#pragma unroll
            for (int r = 0; r < 2; ++r) { const float mean = wave_sum(sm[r]) * (1.f / 2048.f); float s2 = 0.f;
#pragma unroll
                for (int j = 0; j < 8; ++j) { v[r][j] = v[r][j] - mean; s2 += (v[r][j][0] * v[r][j][0] + v[r][j][1] * v[r][j][1]) + (v[r][j][2] * v[r][j][2] + v[r][j][3] * v[r][j][3]); }
                rstd[r] = 1.f / sqrtf(wave_sum(s2) * (1.f / 2048.f) + EPS); }
#pragma unroll
            for (int j = 0; j < 8; ++j) { const int c = 4 * lane + 256 * j; const f32x4 sh = *(const Gf32x4*)(md + c), scv = *(const Gf32x4*)(md + 2048 + c) + 1.f;
#pragma unroll
                for (int r = 0; r < 2; ++r) st4bf(U + (size_t)(row + r) * 2048 + c, v[r][j] * rstd[r] * scv + sh); }
        }
        SEAM(1);
    }

    for (int l = 0; l < NL; ++l) {
        const int pb = 2 + 10 * l; const bool last = (l == NL - 1);
        const int nMall = last ? 32 : 36;
        const float lam_init = 0.8f - 0.6f * __expf(-0.3f * (float)l);
        if (IN(pb + 0)) {
            PHASE_PTRS(); PHASE_IDS();
            pg8::Plain g{WSP(bf16_t, WS_U), WSP(bf16_t, WS_WIN) + (size_t)l * NP * 2048, 2048, 2048, 2048};
            pg8::RectOrder S; if (last) S.init(32, 38, G, bid, 32, 4, 7); else S.init(36, 38, G, bid);
            EpiIn E{ws, INP(I_BGATE) + (size_t)l * 6144};
            pg8::gemm_phase<pg8::Plain, EpiIn, pg8::RectOrder>(lds, g, S, E);
            SEAM(pb + 0);
        }
        if (IN(pb + 1)) {
            PHASE_PTRS(); PHASE_IDS();
            const GB* PIN = WSP(bf16_t, WS_PIN); GB* PL = WSP(bf16_t, WS_PL);
            {
                const int nrows = nMall * 256;
                for (int i = bid * 512 + tid; i < nrows * 64; i += G * 512) {
                    const int row = i >> 6, c8 = (i & 63) * 8, gi = c8 >> 7, half = 1 << gi;
                    int t, s, base; if (row < TL) { t = row & 2047; s = 2048; base = row - t; } else { t = (row - TL) & 255; s = 256; base = row - t; }
                    const int lo_ = t - half < 0 ? 0 : t - half, hi_ = t + half > s ? s : t + half;
                    float a[8] = {0.f, 0.f, 0.f, 0.f, 0.f, 0.f, 0.f, 0.f};
                    for (int q = lo_; q < hi_; ++q) { const u32x4 w = *(const Gu32x4*)(PIN + (size_t)(base + q) * 512 + c8);
                        a[0] += bflo(w.x); a[1] += bfhi(w.x); a[2] += bflo(w.y); a[3] += bfhi(w.y); a[4] += bflo(w.z); a[5] += bfhi(w.z); a[6] += bflo(w.w); a[7] += bfhi(w.w); }
                    const float inv = 1.f / (float)(hi_ - lo_); const u32x4 w = *(const Gu32x4*)(PIN + (size_t)row * 512 + c8);
                    u32x4 o; o.x = pk2(a[0] * inv - bflo(w.x), a[1] * inv - bfhi(w.x)); o.y = pk2(a[2] * inv - bflo(w.y), a[3] * inv - bfhi(w.y));
                    o.z = pk2(a[4] * inv - bflo(w.z), a[5] * inv - bfhi(w.z)); o.w = pk2(a[6] * inv - bflo(w.w), a[7] * inv - bfhi(w.w));
                    *(Gu32x4*)(PL + (size_t)row * 512 + c8) = o;
                }
            }
            { pg8::Plain g{WSP(bf16_t, WS_CKV), WSP(bf16_t, WS_WUKV) + (size_t)l * 2048 * 512, 512, 512, 512}; pg8::RectOrder S; S.init(36, 8, G, bid);
              EpiKV E{WSP(bf16_t, WS_KN), WSP(bf16_t, WS_VM), WSP(float, WS_SSQKV)}; pg8::gemm_phase<pg8::Plain, EpiKV, pg8::RectOrder>(lds, g, S, E); }
            { pg8::Plain g{WSP(bf16_t, WS_CQ), WSP(bf16_t, WS_WUQ) + (size_t)l * 1536 * 768, 768, 768, 768}; pg8::RectOrder S; S.init(nMall, 6, G, bid); if ((G & 7) == 0 && G > nMall * 6) S.rot0 = (G - nMall * 6) & ~7;
              EpiQ E{WSP(bf16_t, WS_QM), WSP(float, WS_SSQQ), WSP(float, WS_ROPE), WSP(float, WS_ROPE) + 1024}; pg8::gemm_phase<pg8::Plain, EpiQ, pg8::RectOrder>(lds, g, S, E); }
            SEAM(pb + 1);
        }
        if (IN(pb + 2)) {
            PHASE_PTRS(); PHASE_IDS();
#ifndef NO_POOLG
            { pg8::Plain g{WSP(bf16_t, WS_PL), WSP(bf16_t, WS_WPL) + (size_t)l * 512 * 512, 512, 512, 512}; pg8::RectOrder S; S.init(nMall, 2, G, bid); if ((G & 7) == 0 && G > nMall * 2) S.rot0 = (G - nMall * 2) & ~7;
              EpiBf E{WSP(bf16_t, WS_OP), 512}; pg8::gemm_phase<pg8::Plain, EpiBf, pg8::RectOrder>(lds, g, S, E); }
#endif
            float lamv;
            { const GF* lp = INP(I_LAM) + (size_t)l * 256; const float sa = wave_sum(lp[lane] * lp[64 + lane]), sb = wave_sum(lp[128 + lane] * lp[192 + lane]); lamv = (expf(sa) - expf(sb)) + lam_init; }
#ifndef NO_MLA
            for (int un = bid; un < (last ? 256 : 288); un += G) {
                att::Args a; a.lamv = 0.f; a.osc = 0.f; a.gsub = INP(I_GSUB); a.KR = WSP(bf16_t, WS_KR); int b, h;
                if (un < 256) { b = un >> 6; h = (un >> 3) & 7; a.qrow0 = b * 2048 + (un & 7) * 256; a.nt = 36; }
                else { const int v = un - 256; b = v >> 3; h = v & 7; a.qrow0 = TL + b * 256; a.nt = 4; }
                a.nt_ctx = 4; a.ctx_row0 = TL + b * 256; a.lat_row0 = b * 2048;
                a.Q = WSP(bf16_t, WS_QM); a.ldq = 1536; a.qcol = h * 192; a.K = WSP(bf16_t, WS_KN); a.V = WSP(bf16_t, WS_VM); a.ldk = 1024; a.kcol = h * 128; a.O = WSP(bf16_t, WS_OM); a.ldo = 1024; a.ocol = h * 128;
                att::attn_unit<0>(a, lds);
            }
#endif
#ifndef NO_DIFF
            for (int un0 = bid; un0 < (last ? 256 : (G == 256 ? 320 : 288)); un0 += G) {
                int un = un0; if (G == 256 && un0 >= 256) { if (un0 < 288) continue; un = un0 - 32; }
                att::Args a; a.lamv = lamv; a.osc = 1.f - lam_init; a.gsub = INP(I_GSUB) + (size_t)l * 128; a.KR = WSP(bf16_t, WS_KR); int b, h;
                if (un < 256) { b = un >> 6; h = (un >> 4) & 3; a.qrow0 = b * 2048 + (un & 15) * 128; a.nt = 36; }
                else { const int v = un - 256; b = v >> 3; h = (v >> 1) & 3; a.qrow0 = TL + b * 256 + (v & 1) * 128; a.nt = 4; }
                a.nt_ctx = 4; a.ctx_row0 = TL + b * 256; a.lat_row0 = b * 2048;
                a.Q = WSP(bf16_t, WS_QD); a.ldq = 512; a.qcol = h * 128; a.K = WSP(bf16_t, WS_KD); a.V = WSP(bf16_t, WS_VD); a.ldk = 512; a.kcol = h * 128; a.O = WSP(bf16_t, WS_OD); a.ldo = 512; a.ocol = h * 128;
                att::attn_unit<1>(a, lds);
            }
#endif
            SEAM(pb + 2);
        }
        if (IN(pb + 3)) {
            PHASE_PTRS(); PHASE_IDS();
            GB* MG = WSP(bf16_t, WS_MG); const GB* GT = WSP(bf16_t, WS_GT);
            pg8::RectOrder S; S.init(nMall, 8, G, bid); GU* flg = ctl + CW_FLG + l * 2048;
            const int rstep = (G >= 192 && (G & 7) == 0) ? 64 : 0;
            { pg8::Plain g{WSP(bf16_t, WS_OM), WSP(bf16_t, WS_WBM) + (size_t)l * 2048 * 1024, 1024, 1024, 1024}; EpiMerge<0> E{MG, GT, flg}; pg8::gemm_phase<pg8::Plain, EpiMerge<0>, pg8::RectOrder>(lds, g, S, E); }
            S.rot = rstep;
            { pg8::Plain g{WSP(bf16_t, WS_OD), WSP(bf16_t, WS_WBD) + (size_t)l * 2048 * 512, 512, 512, 512}; EpiMerge<1> E{MG, GT, flg}; pg8::gemm_phase<pg8::Plain, EpiMerge<1>, pg8::RectOrder>(lds, g, S, E); }
            S.rot = 2 * rstep;
            { pg8::Plain g{WSP(bf16_t, WS_OP), WSP(bf16_t, WS_WBP) + (size_t)l * 2048 * 512, 512, 512, 512}; EpiMerge<2> E{MG, GT, flg}; pg8::gemm_phase<pg8::Plain, EpiMerge<2>, pg8::RectOrder>(lds, g, S, E); }
            SEAM(pb + 3);
        }
        if (IN(pb + 4)) {
            PHASE_PTRS(); PHASE_IDS();
            pg8::Plain g{WSP(bf16_t, WS_MG), WSP(bf16_t, WS_WO) + (size_t)l * 2048 * 2048, 2048, 2048, 2048}; pg8::RectOrder S; S.init(nMall, 8, G, bid);
            EpiWo E{WSP(bf16_t, WS_XS), WSP(float, WS_MOD) + (size_t)l * 5 * 12288, INP(I_X), INP(I_CTX) - (size_t)TL * 2048, l == 0}; pg8::gemm_phase<pg8::Plain, EpiWo, pg8::RectOrder>(lds, g, S, E);
            SEAM(pb + 4);
        }
        if (IN(pb + 5)) {
            PHASE_PTRS(); PHASE_IDS();
            const GF* modl = WSP(float, WS_MOD) + (size_t)l * 5 * 12288; const GB* XS = WSP(bf16_t, WS_XS); GB* VB = WSP(bf16_t, WS_VB); GI* TOPK = WSP(int, WS_TOPK);
            const GF* ln1_g = INP(I_LN1G); const GF* ln1_b = INP(I_LN1B); const GF* b_grp = INP(I_BGRP); const GF* b_exp = INP(I_BEXP);
            const int nrows = nMall * 256; GB* VLO = WSP(bf16_t, WS_VLO);
            for (int pr = gw; pr < nrows / 2; pr += NGW) {
                const int row = 2 * pr; const int mrow = row < TL ? (row >> 11) : 4; const GF* md = modl + (size_t)mrow * 12288;
                f32x4 v[2][8]; float sm[2] = {0.f, 0.f}, rstd[2];
#pragma unroll
                for (int r = 0; r < 2; ++r)
#pragma unroll
                    for (int j = 0; j < 8; ++j) v[r][j] = ld4bf(XS + (size_t)(row + r) * 2048 + 4 * lane + 256 * j);
#pragma unroll
                for (int r = 0; r < 2; ++r) {
#pragma unroll
                    for (int j = 0; j < 8; ++j) sm[r] += (v[r][j][0] + v[r][j][1]) + (v[r][j][2] + v[r][j][3]);
                    const float mean = wave_sum(sm[r]) * (1.f / 2048.f); float s2 = 0.f;
#pragma unroll
                    for (int j = 0; j < 8; ++j) { v[r][j] = v[r][j] - mean; s2 += (v[r][j][0] * v[r][j][0] + v[r][j][1] * v[r][j][1]) + (v[r][j][2] * v[r][j][2] + v[r][j][3] * v[r][j][3]); }
                    rstd[r] = 1.f / sqrtf(wave_sum(s2) * (1.f / 2048.f) + EPS); sm[r] = 0.f;
                    if (lane == 0) { GF* stp = WSP(float, WS_SSQKV) + (size_t)(row + r) * 8; stp[0] = mean; stp[1] = rstd[r]; } }
#pragma unroll
                for (int j = 0; j < 8; ++j) { const int c = 4 * lane + 256 * j; const f32x4 gg = *(const Gf32x4*)(ln1_g + l * 2048 + c), bb = *(const Gf32x4*)(ln1_b + l * 2048 + c);
#pragma unroll
                    for (int r = 0; r < 2; ++r) { v[r][j] = v[r][j] * rstd[r] * gg + bb; sm[r] += (v[r][j][0] + v[r][j][1]) + (v[r][j][2] + v[r][j][3]); } }
#pragma unroll
                for (int r = 0; r < 2; ++r) { const float mean = wave_sum(sm[r]) * (1.f / 2048.f); float s2 = 0.f;
#pragma unroll
                    for (int j = 0; j < 8; ++j) { v[r][j] = v[r][j] - mean; s2 += (v[r][j][0] * v[r][j][0] + v[r][j][1] * v[r][j][1]) + (v[r][j][2] * v[r][j][2] + v[r][j][3] * v[r][j][3]); }
                    rstd[r] = 1.f / sqrtf(wave_sum(s2) * (1.f / 2048.f) + EPS); }
#pragma unroll
                for (int j = 0; j < 8; ++j) { const int c = 4 * lane + 256 * j; const f32x4 scv = *(const Gf32x4*)(md + 4 * 2048 + c) + 1.f, sh = *(const Gf32x4*)(md + 3 * 2048 + c);
#pragma unroll
                    for (int r = 0; r < 2; ++r) { const f32x4 x = v[r][j] * rstd[r] * scv + sh; st4bf(VB + (size_t)(row + r) * 2048 + c, x);
                        f32x4 lo_;
#pragma unroll
                        for (int q = 0; q < 4; ++q) lo_[q] = x[q] - __builtin_bit_cast(float, f2bf(x[q]) << 16);
                        st4bf(VLO + (size_t)(row + r) * 2048 + c, lo_); } }
            }
            SEAM_MID();
            { RouterP g{VB, WSP(bf16_t, WS_VLO), WSP(bf16_t, WS_WRT) + (size_t)l * 2 * 256 * 2048, WSP(bf16_t, WS_WRT) + ((size_t)l * 2 + 1) * 256 * 2048, 1024, 2048, 2048};
              SliceOrder S{nMall, G, bid}; EpiRouter E{WSP(float, WS_RP)}; pg8::gemm_phase<RouterP, EpiRouter, SliceOrder>(lds, g, S, E); }
            SEAM_MID();
            LAS unsigned* lcnt = (LAS unsigned*)lds;
            if (tid < 64) lcnt[tid] = 0u;
            __syncthreads();
            for (int row = gw; row < nrows; row += NGW) {
                const GF* rp = WSP(float, WS_RP) + (size_t)row * 80; float lg = 0.f, le = 0.f;
#pragma unroll
                for (int q = 0; q < 6; ++q) { le += rp[(size_t)q * T * 80 + 8 + lane]; if (lane < 8) lg += rp[(size_t)q * T * 80 + lane]; }
                if (lane < 8) lg += b_grp[l * 8 + lane];
                le += b_exp[l * 64 + lane];
                float gl[8];
#pragma unroll
                for (int q = 0; q < 8; ++q) gl[q] = __shfl(lg, q);
                int gi = 0; float gm = gl[0];
#pragma unroll
                for (int q = 1; q < 8; ++q) if (gl[q] > gm) { gm = gl[q]; gi = q; }
                float gs = 0.f;
#pragma unroll
                for (int q = 0; q < 8; ++q) gs += expf(gl[q] - gm);
                const float grp_p = 1.f / gs;
                float el[8];
#pragma unroll
                for (int q = 0; q < 8; ++q) el[q] = __shfl(le, gi * 8 + q);
                int i1 = 0; float v1 = el[0];
#pragma unroll
                for (int q = 1; q < 8; ++q) if (el[q] > v1) { v1 = el[q]; i1 = q; }
                int i2 = -1; float v2 = -3.4e38f;
#pragma unroll
                for (int q = 0; q < 8; ++q) if (q != i1 && el[q] > v2) { v2 = el[q]; i2 = q; }
                const float e2 = expf(v2 - v1), w0 = grp_p / (1.f + e2), w1 = grp_p * e2 / (1.f + e2);
                if (lane == 0) { const int e0 = gi * 8 + i1, e1 = gi * 8 + i2;
                    const int p0 = (int)__hip_atomic_fetch_add(lcnt + e0, 1u, __ATOMIC_RELAXED, __HIP_MEMORY_SCOPE_WORKGROUP), p1 = (int)__hip_atomic_fetch_add(lcnt + e1, 1u, __ATOMIC_RELAXED, __HIP_MEMORY_SCOPE_WORKGROUP);
                    GI* tk = TOPK + (size_t)row * 8; tk[0] = e0; tk[1] = e1; ((GF*)tk)[2] = w0; ((GF*)tk)[3] = w1; tk[4] = p0; tk[5] = p1; }
            }
            __syncthreads();
            if (tid < 64) ctl[CW_HIST + (l * 512 + bid) * 64 + tid] = lcnt[tid];
            __syncthreads();
            SEAM(pb + 5);
        }
        if (IN(pb + 6)) {
            PHASE_PTRS(); PHASE_IDS();
            GI* TE = WSP(int, WS_TE) + l * 256; GI* TV = WSP(int, WS_TE) + 512 + l * 128; GI* TOPK = WSP(int, WS_TOPK); GI* S2T = WSP(int, WS_XG);
            LAS int* soff = (LAS int*)lds;
            LAS int* tot = soff + 64;
            {
                LAS int* part = soff + 256;
                const int e_ = tid & 63, q_ = tid >> 6, b_lo = (G * q_) >> 3, b_hi = (G * (q_ + 1)) >> 3; int pre = 0, t_ = 0;
#pragma unroll 8
                for (int b2 = b_lo; b2 < b_hi; ++b2) { const int cn = (int)ctl[CW_HIST + (l * 512 + b2) * 64 + e_]; pre += b2 < bid ? cn : 0; t_ += cn; }
                part[q_ * 64 + e_] = pre; part[512 + q_ * 64 + e_] = t_;
                __syncthreads();
                if (tid < 64) { int a = 0, b = 0;
#pragma unroll
                    for (int q = 0; q < 8; ++q) { a += part[q * 64 + tid]; b += part[512 + q * 64 + tid]; }
                    soff[tid] = a; tot[tid] = b; }
                __syncthreads();
            }
            LAS int* stf = soff + 128;
            if (tid < 64) {
                const int te_ = tot[tid], nt_ = (te_ + STROWS - 1) / STROWS; int incl = nt_;
#pragma unroll
                for (int d = 1; d < 64; d <<= 1) { const int v_ = __shfl_up(incl, d); if (lane >= d) incl += v_; }
                const int first = incl - nt_; stf[tid] = first;
                if (bid == 0) { for (int q = 0; q < nt_; ++q) { TE[first + q] = tid; const int rem = te_ - STROWS * q; TV[first + q] = rem < STROWS ? rem : STROWS; }
                    if (tid == 63) TE[200] = incl; } }
            __syncthreads();
            const int nrows = nMall * 256;
            for (int row = (tid >> 3) * NGW + bid * NWAVES + (tid & 7); row < nrows; row += 64 * NGW) {
                GI* tk = TOPK + (size_t)row * 8; const int e0 = tk[0], e1 = tk[1], p0 = soff[e0] + tk[4], p1 = soff[e1] + tk[5], s0 = (stf[e0] + p0 / STROWS) * 512 + p0 % STROWS, s1 = (stf[e1] + p1 / STROWS) * 512 + p1 % STROWS;
                tk[6] = s0; tk[7] = s1; S2T[s0] = row; S2T[s1] = row;
            }
            __syncthreads();
            SEAM(pb + 6);
        }
        if (IN(pb + 7)) {
            PHASE_PTRS(); PHASE_IDS();
            const GI* TE = WSP(int, WS_TE) + l * 256;
            mg::moe_gemm<0>(lds, WSP(bf16_t, WS_VB), INP(I_WGU) + (size_t)l * NEXP * 2048 * 1024, WSP(bf16_t, WS_HB), TE, WSP(int, WS_TE) + 512 + l * 128, WSP(int, WS_XG), __hip_atomic_load(TE + 200, __ATOMIC_RELAXED, __HIP_MEMORY_SCOPE_AGENT), G, bid);
            SEAM(pb + 7);
        }
        if (IN(pb + 8)) {
            PHASE_PTRS(); PHASE_IDS();
            const GI* TE = WSP(int, WS_TE) + l * 256;
            mg::moe_gemm<1>(lds, WSP(bf16_t, WS_HB), INP(I_WDN) + (size_t)l * NEXP * 512 * 2048, WSP(bf16_t, WS_YB), TE, WSP(int, WS_TE) + 512 + l * 128, WSP(int, WS_XG), __hip_atomic_load(TE + 200, __ATOMIC_RELAXED, __HIP_MEMORY_SCOPE_AGENT), G, bid);
            SEAM(pb + 8);
        }
        if (IN(pb + 9)) {
            PHASE_PTRS(); PHASE_IDS();
            const GF* MOD = WSP(float, WS_MOD); const GF* modl = MOD + (size_t)l * 5 * 12288; GB* XS = WSP(bf16_t, WS_XS); GB* U = WSP(bf16_t, WS_U); const GI* TOPK = WSP(int, WS_TOPK); const GB* YB = WSP(bf16_t, WS_YB);
            const GF* ln2_g = INP(I_LN2G); const GF* ln2_b = INP(I_LN2B); GF* outp = (GF*)*(const unsigned long long __attribute__((address_space(4)))*)(kp + 240);
            const int nrows = nMall * 256;
            for (int pr = gw; pr < nrows / 2; pr += NGW) {
                const int row = 2 * pr; const int mrow = row < TL ? (row >> 11) : 4; const GF* md = modl + (size_t)mrow * 12288;
                float w0[2], w1[2]; int s0[2], s1[2];
#pragma unroll
                for (int r = 0; r < 2; ++r) { const GI* tk = TOPK + (size_t)(row + r) * 8; w0[r] = ((const GF*)tk)[2]; w1[r] = ((const GF*)tk)[3]; s0[r] = tk[6]; s1[r] = tk[7]; }
                float mu1[2], rs1[2];
#pragma unroll
                for (int r = 0; r < 2; ++r) { const GF* stp = WSP(float, WS_SSQKV) + (size_t)(row + r) * 8; mu1[r] = stp[0]; rs1[r] = stp[1]; }
                f32x4 v[2][8]; float sm[2] = {0.f, 0.f}, rstd[2];
#pragma unroll
                for (int j = 0; j < 8; ++j) { const int c = 4 * lane + 256 * j; const f32x4 g2 = *(const Gf32x4*)(md + 5 * 2048 + c), gg1 = *(const Gf32x4*)(INP(I_LN1G) + l * 2048 + c), bb1 = *(const Gf32x4*)(INP(I_LN1B) + l * 2048 + c);
#pragma unroll
                    for (int r = 0; r < 2; ++r) { const f32x4 y = ld4bf(YB + (size_t)s0[r] * 2048 + c) * w0[r] + ld4bf(YB + (size_t)s1[r] * 2048 + c) * w1[r];
                        v[r][j] = ((ld4bf(XS + (size_t)(row + r) * 2048 + c) - mu1[r]) * rs1[r] * gg1 + bb1) * DN_ALPHA + g2 * y; sm[r] += (v[r][j][0] + v[r][j][1]) + (v[r][j][2] + v[r][j][3]); } }
#pragma unroll
                for (int r = 0; r < 2; ++r) { const float mean = wave_sum(sm[r]) * (1.f / 2048.f); float s2 = 0.f;
#pragma unroll
                    for (int j = 0; j < 8; ++j) { v[r][j] = v[r][j] - mean; s2 += (v[r][j][0] * v[r][j][0] + v[r][j][1] * v[r][j][1]) + (v[r][j][2] * v[r][j][2] + v[r][j][3] * v[r][j][3]); }
                    rstd[r] = 1.f / sqrtf(wave_sum(s2) * (1.f / 2048.f) + EPS); sm[r] = 0.f; }
#pragma unroll
                for (int j = 0; j < 8; ++j) { const int c = 4 * lane + 256 * j; const f32x4 gg = *(const Gf32x4*)(ln2_g + l * 2048 + c), bb = *(const Gf32x4*)(ln2_b + l * 2048 + c);
#pragma unroll
                    for (int r = 0; r < 2; ++r) { v[r][j] = v[r][j] * rstd[r] * gg + bb; sm[r] += (v[r][j][0] + v[r][j][1]) + (v[r][j][2] + v[r][j][3]);
                        if (last) *(Gf32x4*)(outp + (size_t)(row + r) * 2048 + c) = v[r][j]; else st4bf(XS + (size_t)(row + r) * 2048 + c, v[r][j]); } }
                if (!last) {
                    const GF* mn = MOD + ((size_t)(l + 1) * 5 + mrow) * 12288;
#pragma unroll
                    for (int r = 0; r < 2; ++r) { const float mean = wave_sum(sm[r]) * (1.f / 2048.f); float s2 = 0.f;
#pragma unroll
                        for (int j = 0; j < 8; ++j) { v[r][j] = v[r][j] - mean; s2 += (v[r][j][0] * v[r][j][0] + v[r][j][1] * v[r][j][1]) + (v[r][j][2] * v[r][j][2] + v[r][j][3] * v[r][j][3]); }
                        rstd[r] = 1.f / sqrtf(wave_sum(s2) * (1.f / 2048.f) + EPS); }
#pragma unroll
                    for (int j = 0; j < 8; ++j) { const int c = 4 * lane + 256 * j; const f32x4 scv = *(const Gf32x4*)(mn + 2048 + c) + 1.f, sh = *(const Gf32x4*)(mn + c);
#pragma unroll
                        for (int r = 0; r < 2; ++r) st4bf(U + (size_t)(row + r) * 2048 + c, v[r][j] * rstd[r] * scv + sh); }
                }
            }
            SEAM(pb + 9);
        }
    }
#undef IN
#undef SEAM
}


extern "C" void kernel_launch(void* const* d_in, const int* in_sizes, int n_in, void* d_out, int out_size, void* d_ws, size_t ws_size, hipStream_t stream) {
    static int grid = 0;
    if (grid == 0) {
        if (n_in != 30 || out_size != TL * D || ws_size < WS_END) { fprintf(stderr, "kernel_launch: unexpected shapes (n_in %d out %d ws %zu need %zu)\n", n_in, out_size, ws_size, (size_t)WS_END); grid = -1; return; }
        int dev = 0, cus = 0, per_cu = 0;
        if (hipGetDevice(&dev) != hipSuccess || hipDeviceGetAttribute(&cus, hipDeviceAttributeMultiprocessorCount, dev) != hipSuccess) { grid = -1; return; }
        if (hipFuncSetAttribute((const void*)fwd, hipFuncAttributeMaxDynamicSharedMemorySize, LDS_BYTES) != hipSuccess) { fprintf(stderr, "kernel_launch: hipFuncSetAttribute failed\n"); grid = -1; return; }
        if (hipOccupancyMaxActiveBlocksPerMultiprocessor(&per_cu, (const void*)fwd, NWAVES * 64, LDS_BYTES) != hipSuccess || per_cu < 1) fprintf(stderr, "kernel_launch: occupancy query reports %d\n", per_cu);
        (void)hipGetLastError();
        grid = cus;
    }
    if (grid < 0) return;
    (void)hipMemsetAsync((char*)d_ws + WS_CTL, 0, CTL_BYTES, stream);
    Args a{};
    for (int i = 0; i < 30; ++i) a.in[i] = (const float*)d_in[i];
    a.out = (float*)d_out; a.ws = (unsigned char*)d_ws;
#if MK_N_LAUNCHES == 1
#if defined(DBG_PREFIX)
    a.ph_lo = 0; a.ph_hi = DBG_PREFIX; a.region = 1; hipLaunchKernelGGL(fwd, dim3(grid), dim3(NWAVES * 64), LDS_BYTES, stream, a);
#endif
    a.ph_lo = 0; a.ph_hi = NPHASE; a.region = 0;
    hipLaunchKernelGGL(fwd, dim3(grid), dim3(NWAVES * 64), LDS_BYTES, stream, a);
#else
    for (int p = 0; p < NPHASE; ++p) { a.ph_lo = p; a.ph_hi = p + 1; hipLaunchKernelGGL(fwd, dim3(grid), dim3(NWAVES * 64), LDS_BYTES, stream, a); }
#endif
    const hipError_t le = hipPeekAtLastError();
    if (le != hipSuccess) fprintf(stderr, "kernel_launch: launch failed: %s\n", hipGetErrorName(le));
}
```

```cpp
#include <hip/hip_runtime.h>
#include <cstdio>
#include <cstdint>

#ifndef MK_N_LAUNCHES
#define MK_N_LAUNCHES 1
#endif

#define GAS __attribute__((address_space(1)))
#define LAS __attribute__((address_space(3)))
typedef unsigned short bf16_t;
typedef short bf16x8 __attribute__((ext_vector_type(8)));
typedef short s16x4 __attribute__((ext_vector_type(4)));
typedef float f32x4 __attribute__((ext_vector_type(4)));
typedef float f32x16 __attribute__((ext_vector_type(16)));
typedef unsigned u32x4 __attribute__((ext_vector_type(4)));
typedef unsigned u32x2 __attribute__((ext_vector_type(2)));
typedef GAS bf16_t GB; typedef GAS float GF; typedef GAS int GI; typedef GAS unsigned GU; typedef GAS unsigned char GC;
typedef GAS f32x4 Gf32x4; typedef GAS u32x4 Gu32x4; typedef GAS u32x2 Gu32x2; typedef GAS bf16x8 Gbf16x8;
typedef __attribute__((address_space(4))) const unsigned char CKA;

constexpr int D = 2048, NB = 4, SEQ = 2048, CTX = 256, NL = 2;
constexpr int TL = NB * SEQ, TC = NB * CTX, T = TL + TC;
constexpr int NP = 9728;
constexpr int IN_COLS = 9536;
constexpr int NEXP = 64, DEXP = 512;
constexpr int STROWS = 384, MAXST = 112, MAXSLOTS = MAXST * 512;
constexpr float EPS = 1e-6f;
constexpr float DN_ALPHA = 1.4142135623730951f;
constexpr float LOG2E = 1.4426950408889634f;

__device__ __forceinline__ unsigned f2bf(float f) { unsigned u = __builtin_bit_cast(unsigned, f); return (u + 0x7fffu + ((u >> 16) & 1u)) >> 16; }
__device__ __forceinline__ unsigned pk2(float lo, float hi) { return f2bf(lo) | (f2bf(hi) << 16); }
__device__ __forceinline__ float bf2f(unsigned short b) { return __builtin_bit_cast(float, ((unsigned)b) << 16); }
__device__ __forceinline__ float bflo(unsigned w) { return __builtin_bit_cast(float, w << 16); }
__device__ __forceinline__ float bfhi(unsigned w) { return __builtin_bit_cast(float, w & 0xffff0000u); }
typedef float f32x2_t __attribute__((ext_vector_type(2)));
typedef __bf16 bf16x2_t __attribute__((ext_vector_type(2)));
__device__ __forceinline__ unsigned cvt_pk_bf16(float lo, float hi) { f32x2_t v = {lo, hi}; bf16x2_t b = __builtin_convertvector(v, bf16x2_t); return __builtin_bit_cast(unsigned, b); }
__device__ __forceinline__ void st4bf(GB* p, f32x4 v) { u32x2 w; w.x = cvt_pk_bf16(v[0], v[1]); w.y = cvt_pk_bf16(v[2], v[3]); *(Gu32x2*)p = w; }
__device__ __forceinline__ f32x4 ld4bf(const GB* p) { const u32x2 w = *(const Gu32x2*)p; return (f32x4){bflo(w.x), bfhi(w.x), bflo(w.y), bfhi(w.y)}; }
__device__ __forceinline__ void st8bf(GB* p, f32x4 a, f32x4 b) { u32x4 w; w.x = cvt_pk_bf16(a[0], a[1]); w.y = cvt_pk_bf16(a[2], a[3]); w.z = cvt_pk_bf16(b[0], b[1]); w.w = cvt_pk_bf16(b[2], b[3]); *(Gu32x4*)p = w; }
__device__ __forceinline__ void ld8bf(const GB* p, f32x4& a, f32x4& b) { const u32x4 w = *(const Gu32x4*)p; a = (f32x4){bflo(w.x), bfhi(w.x), bflo(w.y), bfhi(w.y)}; b = (f32x4){bflo(w.z), bfhi(w.z), bflo(w.w), bfhi(w.w)}; }
__device__ __forceinline__ float wave_sum(float v) {
#pragma unroll
    for (int o = 1; o < 64; o <<= 1) v += __shfl_xor(v, o);
    return v;
}

namespace pg8 {
constexpr int BM = 256, BK = 64, HALF = 128, HTB = HALF * BK * 2, STAGE_BYTES = 8 * HTB, NXCD = 8, WGM = 8;
__host__ __device__ __forceinline__ int lds_byte(int r, int c) { const int st = (r >> 4) * 2 + (c >> 5), rr = r & 15, cc = c & 31, ob = rr * 64 + cc * 2; return st * 1024 + (ob ^ (((ob >> 9) & 1) << 5)); }
__host__ __device__ __forceinline__ void stage_rc(int b, int& R, int& C) { const int st = b / 1024, sb = b % 1024, swz = sb ^ (((sb >> 9) & 1) << 5); R = (st >> 1) * 16 + swz / 64; C = (st & 1) * 32 + (swz % 64) / 2; }

struct Unit { int pm, pn, ex; };

struct Plain {
    const GB* A; const GB* Bt; int K, lda, ldb; static constexpr int kstepB = BK * 2;
    __device__ __forceinline__ const GAS char* aptr(const Unit& u) const { return (const GAS char*)(A + (size_t)u.pm * BM * lda); }
    __device__ __forceinline__ const GAS char* bptr(const Unit& u) const { return (const GAS char*)(Bt + (size_t)u.pn * BM * ldb); }
};
struct Grouped {
    const GB* A; const GB* Bt; int K, lda; size_t estride; static constexpr int ldb = 64, kstepB = 256 * 64 * 2;
    __device__ __forceinline__ const GAS char* aptr(const Unit& u) const { return (const GAS char*)(A + (size_t)u.pm * BM * lda); }
    __device__ __forceinline__ const GAS char* bptr(const Unit& u) const { return (const GAS char*)(Bt + (size_t)u.ex * estride + (size_t)u.pn * (K / 64) * 256 * 64); }
};

struct RectOrder {
    int nM, nN, nwg, G, c, pm0b, nMb, nNb, nwgb, rot, rot0;
    __device__ void init(int nM_, int nN_, int G_, int c_, int pm0b_ = 0, int nMb_ = 0, int nNb_ = 0) { nM = nM_; nN = nN_; nwg = nM * nN; G = G_; c = c_; pm0b = pm0b_; nMb = nMb_; nNb = nNb_; nwgb = nMb * nNb; rot = 0; rot0 = 0; }
    __device__ bool next(int i, Unit& u) const {
        const int L = i * G + (c - (i == 0 ? rot0 : rot) + G) % G; u.ex = i == 0 ? 0 : 1 + (L - G);
        if (L < nwg) {
            int wgid = L; { const int q = nwg / NXCD, r = nwg % NXCD, xcd = wgid % NXCD, off = wgid / NXCD; wgid = (xcd < r ? xcd * (q + 1) : r * (q + 1) + (xcd - r) * q) + off; }
            const int nig = WGM * nN, gid = wgid / nig, fm = gid * WGM, gsz = (nM - fm) < WGM ? (nM - fm) : WGM;
            u.pm = fm + ((wgid % nig) % gsz); u.pn = (wgid % nig) / gsz; return true;
        }
        const int L2 = L - nwg; if (L2 >= nwgb) return false;
        u.pm = pm0b + L2 % nMb; u.pn = L2 / nMb; return true;
    }
};
struct TileOrder {
    const GI* te; int ntiles, nN, G, c;
    __device__ bool next(int i, Unit& u) const {
        const int tpr = G / nN;
        int tl, pn;
        if ((G & 7) == 0 && (tpr & 7) == 0) { const int x = c & 7, sl = c >> 3; tl = x * (tpr >> 3) + sl / nN; pn = sl % nN; }
        else { tl = c / nN; pn = c % nN; if (tl >= tpr) return false; }
        const int pm = i * tpr + tl; if (pm >= ntiles) return false;
        u.pm = pm; u.pn = pn; u.ex = __hip_atomic_load(te + pm, __ATOMIC_RELAXED, __HIP_MEMORY_SCOPE_AGENT); return true;
    }
};

template <class Prob, class Epi, class Sched, bool ALIGN_EPI = true, bool SP2 = true>
__device__ __forceinline__ void gemm_phase_stream(LAS unsigned char* lds, const Prob g, const Sched& S, const Epi& E) {
    int tid_ = threadIdx.x; asm volatile("" : "+v"(tid_));
    const int tid = tid_, wid = __builtin_amdgcn_readfirstlane(tid >> 6), lane = tid & 63, wr = wid >> 2, wc = wid & 3, fr = lane & 15, fq = lane >> 4;
    const int K = g.K, nt = K / BK;
    unsigned voffA[2], voffB[2];
#pragma unroll
    for (int i = 0; i < 2; ++i) { int R, C; stage_rc(tid * 16 + i * 8192, R, C); voffA[i] = (unsigned)(R * g.lda + C) * 2u; voffB[i] = (unsigned)(R * g.ldb + C) * 2u; }
    const size_t kstep = (size_t)(BK * 2), kstepB = (size_t)g.kstepB;
    const size_t hstepA = (size_t)HALF * g.lda * 2, hstepB = (size_t)HALF * g.ldb * 2;
    const unsigned ldsw = (unsigned)wid * 1024u;
    const int aoff = lds_byte(wr * 64 + fr, fq * 8), boff = lds_byte(wc * 32 + fr, fq * 8);
#define PG8_SA(b, h) (((b) * 2 + (h)) * HTB)
#define PG8_SB(b, h) ((4 + (b) * 2 + (h)) * HTB)
#define PG8_STAGE(bufoff, gbase, voff) do { _Pragma("unroll") for (int _i = 0; _i < 2; ++_i) \
        __builtin_amdgcn_global_load_lds((const unsigned*)((const GAS char*)(gbase) + (voff)[_i]), (LAS unsigned*)(lds + (bufoff) + ldsw + _i * 8192), 16, 0, 0); } while (0)
#define PG8_LDA(dst, b, h) do { _Pragma("unroll") for (int m = 0; m < 4; ++m) _Pragma("unroll") for (int k = 0; k < 2; ++k) dst[m][k] = *(const LAS bf16x8*)(lds + PG8_SA(b, h) + aoff + m * 2048 + k * 1024); } while (0)
#define PG8_LDB(dst, b, h) do { _Pragma("unroll") for (int n = 0; n < 2; ++n) _Pragma("unroll") for (int k = 0; k < 2; ++k) dst[n][k] = *(const LAS bf16x8*)(lds + PG8_SB(b, h) + boff + n * 2048 + k * 1024); } while (0)
#define PG8_MMA(ai, bj, At, Bt) do { __builtin_amdgcn_s_setprio(1); _Pragma("unroll") for (int m = 0; m < 4; ++m) _Pragma("unroll") for (int n = 0; n < 2; ++n) _Pragma("unroll") for (int k = 0; k < 2; ++k) \
        acc[ai][bj][m][n] = __builtin_amdgcn_mfma_f32_16x16x32_bf16(Bt[n][k], At[m][k], acc[ai][bj][m][n], 0, 0, 0); __builtin_amdgcn_s_setprio(0); } while (0)
#define PG8_WAIT_V(n) asm volatile("s_waitcnt vmcnt(" #n ")" ::: "memory")
#define PG8_WAIT_L(n) asm volatile("s_waitcnt lgkmcnt(" #n ")" ::: "memory")
#define PG8_BAR __builtin_amdgcn_s_barrier()
#define PG8_SCHED __builtin_amdgcn_sched_barrier(0)
    Unit cur, nxt; int ui = 0;
    if (!S.next(0, cur)) return;
    f32x4 acc[2][2][4][2];
#pragma unroll
    for (int a = 0; a < 2; ++a)
#pragma unroll
        for (int b = 0; b < 2; ++b)
#pragma unroll
            for (int m = 0; m < 4; ++m)
#pragma unroll
                for (int n = 0; n < 2; ++n) acc[a][b][m][n] = (f32x4){0.f, 0.f, 0.f, 0.f};
    bf16x8 At[4][2], B0[2][2], B1[2][2];
    const GAS char* cA = g.aptr(cur); const GAS char* cB = g.bptr(cur);
    if constexpr (SP2) {
        PG8_STAGE(PG8_SB(0, 0), cB, voffB); PG8_STAGE(PG8_SB(0, 1), cB + hstepB, voffB); PG8_STAGE(PG8_SA(0, 0), cA, voffA); PG8_STAGE(PG8_SA(0, 1), cA + hstepA, voffA);
        if (wr == 1) PG8_BAR;
        PG8_WAIT_V(2); PG8_BAR;
        PG8_STAGE(PG8_SB(1, 0), cB + kstepB, voffB); PG8_STAGE(PG8_SA(1, 0), cA + kstep, voffA); PG8_STAGE(PG8_SB(1, 1), cB + hstepB + kstepB, voffB);
        PG8_WAIT_V(6); PG8_BAR;
    } else {
        PG8_STAGE(PG8_SB(0, 0), cB, voffB); PG8_STAGE(PG8_SA(0, 0), cA, voffA); PG8_STAGE(PG8_SB(0, 1), cB + hstepB, voffB); PG8_STAGE(PG8_SA(0, 1), cA + hstepA, voffA);
        if (wr == 1) PG8_BAR;
        PG8_WAIT_V(4); PG8_BAR;
        PG8_STAGE(PG8_SB(1, 0), cB + kstepB, voffB); PG8_STAGE(PG8_SA(1, 0), cA + kstep, voffA); PG8_STAGE(PG8_SB(1, 1), cB + hstepB + kstepB, voffB);
        PG8_WAIT_V(6); PG8_BAR;
    }
    for (;;) {
        const bool has_next = S.next(ui + 1, nxt);
        const GAS char* nA = has_next ? g.aptr(nxt) : cA; const GAS char* nB = has_next ? g.bptr(nxt) : cB;
        for (int t = 0; t < nt; t += 2) {
            const bool last = (t == nt - 2);
            const GAS char* a1 = cA + (size_t)(t + 1) * kstep;
            const GAS char* a2 = last ? nA : cA + (size_t)(t + 2) * kstep; const GAS char* b2 = last ? nB : cB + (size_t)(t + 2) * kstepB;
            const GAS char* a3 = a2 + kstep; const GAS char* b3 = b2 + kstepB;
            if constexpr (SP2) {
            PG8_LDB(B0, 0, 0); PG8_LDB(B1, 0, 1); PG8_SCHED; PG8_LDA(At, 0, 0); PG8_STAGE(PG8_SA(1, 1), a1 + hstepA, voffA);
            PG8_WAIT_V(8); PG8_WAIT_L(0); PG8_BAR; PG8_MMA(0, 0, At, B0); PG8_MMA(0, 1, At, B1); PG8_BAR; PG8_SCHED;
            PG8_LDA(At, 0, 1); PG8_STAGE(PG8_SB(0, 0), b2, voffB); PG8_STAGE(PG8_SB(0, 1), b2 + hstepB, voffB); PG8_STAGE(PG8_SA(0, 0), a2, voffA);
            PG8_WAIT_V(8); PG8_WAIT_L(0); PG8_BAR; PG8_MMA(1, 0, At, B0); PG8_MMA(1, 1, At, B1); PG8_BAR; PG8_SCHED;
            PG8_LDB(B0, 1, 0); PG8_LDB(B1, 1, 1); PG8_SCHED; PG8_LDA(At, 1, 0); PG8_STAGE(PG8_SA(0, 1), a2 + hstepA, voffA);
            PG8_WAIT_V(8); PG8_WAIT_L(0); PG8_BAR; PG8_MMA(0, 0, At, B0); PG8_MMA(0, 1, At, B1); PG8_BAR; PG8_SCHED;
            PG8_LDA(At, 1, 1); PG8_STAGE(PG8_SB(1, 0), b3, voffB); PG8_STAGE(PG8_SB(1, 1), b3 + hstepB, voffB); PG8_STAGE(PG8_SA(1, 0), a3, voffA);
            PG8_WAIT_V(8); PG8_WAIT_L(0); PG8_BAR; PG8_MMA(1, 0, At, B0); PG8_MMA(1, 1, At, B1); PG8_BAR; PG8_SCHED;
            } else {
            PG8_LDB(B0, 0, 0); PG8_SCHED; PG8_LDA(At, 0, 0); PG8_STAGE(PG8_SA(1, 1), a1 + hstepA, voffA);
            PG8_WAIT_L(8); PG8_BAR; PG8_WAIT_L(0); PG8_MMA(0, 0, At, B0); PG8_BAR; PG8_SCHED;
            PG8_LDB(B1, 0, 1); PG8_STAGE(PG8_SB(0, 0), b2, voffB);
            PG8_BAR; PG8_WAIT_L(0); PG8_MMA(0, 1, At, B1); PG8_BAR;
            PG8_LDA(At, 0, 1); PG8_STAGE(PG8_SA(0, 0), a2, voffA);
            PG8_BAR; PG8_WAIT_L(0); PG8_MMA(1, 0, At, B0); PG8_BAR; PG8_SCHED;
            PG8_STAGE(PG8_SB(0, 1), b2 + hstepB, voffB);
            PG8_WAIT_V(6); PG8_BAR; PG8_MMA(1, 1, At, B1); PG8_BAR;
            PG8_LDB(B0, 1, 0); PG8_SCHED; PG8_LDA(At, 1, 0); PG8_STAGE(PG8_SA(0, 1), a2 + hstepA, voffA);
            PG8_WAIT_L(8); PG8_BAR; PG8_WAIT_L(0); PG8_MMA(0, 0, At, B0); PG8_BAR; PG8_SCHED;
            PG8_LDB(B1, 1, 1); PG8_STAGE(PG8_SB(1, 0), b3, voffB);
            PG8_BAR; PG8_WAIT_L(0); PG8_MMA(0, 1, At, B1); PG8_BAR;
            PG8_LDA(At, 1, 1); PG8_STAGE(PG8_SA(1, 0), a3, voffA);
            PG8_BAR; PG8_WAIT_L(0); PG8_MMA(1, 0, At, B0); PG8_BAR; PG8_SCHED;
            PG8_STAGE(PG8_SB(1, 1), b3 + hstepB, voffB);
            PG8_WAIT_V(6); PG8_BAR; PG8_MMA(1, 1, At, B1); PG8_BAR;
            }
        }
        if constexpr (ALIGN_EPI) { if (wr == 0) PG8_BAR; }
        { int fr2 = fr, fq2 = fq; asm volatile("" : "+v"(fr2), "+v"(fq2)); E(acc, cur, wr, wc, fr2, fq2); }
        if (!has_next) break;
#pragma unroll
        for (int a = 0; a < 2; ++a)
#pragma unroll
            for (int b = 0; b < 2; ++b)
#pragma unroll
                for (int m = 0; m < 4; ++m)
#pragma unroll
                    for (int n = 0; n < 2; ++n) acc[a][b][m][n] = (f32x4){0.f, 0.f, 0.f, 0.f};
        cur = nxt; cA = nA; cB = nB; ++ui;
        if constexpr (ALIGN_EPI) { if (wr == 1) PG8_BAR; }
    }
    PG8_WAIT_V(0);
    if constexpr (!ALIGN_EPI) { if (wr == 0) PG8_BAR; }
    PG8_BAR;
#undef PG8_SA
#undef PG8_SB
#undef PG8_STAGE
#undef PG8_LDA
#undef PG8_LDB
#undef PG8_MMA
#undef PG8_WAIT_V
#undef PG8_WAIT_L
#undef PG8_BAR
#undef PG8_SCHED
}

struct OneUnit { Unit u; __device__ bool next(int i, Unit& o) const { if (i) return false; o = u; return true; } };
template <class Prob, class Epi, class Sched>
__device__ __forceinline__ void gemm_phase(LAS unsigned char* lds, const Prob g, const Sched& S, const Epi& E) {
#if defined(DBG_ONE_UNIT)
    Unit u; for (int i = 0; S.next(i, u); ++i) { OneUnit O{u}; gemm_phase_stream<Prob, Epi, OneUnit>(lds, g, O, E); }
#else
    gemm_phase_stream<Prob, Epi, Sched>(lds, g, S, E);
#endif
}
}
using pg8::Unit;
typedef const f32x4 (&AccRef)[2][2][4][2];

constexpr size_t al256(size_t x) { return (x + 255) / 256 * 256; }
constexpr size_t WS_CTL = 0, CTL_BYTES = 1u << 20;
constexpr int CW_BAR = 4096;
constexpr int CW_FLG = 20480;
constexpr int CW_CNT = 16384;
constexpr int CW_HIST = 32768;
constexpr size_t WS_MOD = WS_CTL + CTL_BYTES;
constexpr size_t WS_ROPE = WS_MOD + al256((size_t)NL * 5 * 12288 * 4);
constexpr size_t WS_WRT = WS_ROPE + 8192;
constexpr size_t WS_TE = WS_WRT + (size_t)NL * 2 * 256 * 2048 * 2;
constexpr size_t WS_WIN = WS_TE + 4096;
constexpr size_t WS_WUKV = WS_WIN + (size_t)NL * NP * 2048 * 2;
constexpr size_t WS_WUQ = WS_WUKV + (size_t)NL * 2048 * 512 * 2;
constexpr size_t WS_WPL = WS_WUQ + (size_t)NL * 1536 * 768 * 2;
constexpr size_t WS_WBM = WS_WPL + (size_t)NL * 512 * 512 * 2;
constexpr size_t WS_WBD = WS_WBM + (size_t)NL * 2048 * 1024 * 2;
constexpr size_t WS_WBP = WS_WBD + (size_t)NL * 2048 * 512 * 2;
constexpr size_t WS_WO = WS_WBP + (size_t)NL * 2048 * 512 * 2;
constexpr size_t WS_XS = WS_WO + (size_t)NL * 2048 * 2048 * 2;
constexpr size_t WS_U = WS_XS + (size_t)T * 2048 * 4;
constexpr size_t WS_CKV = WS_U + (size_t)T * 2048 * 2;
constexpr size_t WS_KD = WS_CKV + (size_t)T * 512 * 2;
constexpr size_t WS_VD = WS_KD + (size_t)T * 512 * 2;
constexpr size_t WS_KR = WS_VD + (size_t)T * 512 * 2;
constexpr size_t WS_CQ = WS_KR + (size_t)T * 64 * 2;
constexpr size_t WS_QD = WS_CQ + (size_t)T * 768 * 2;
constexpr size_t WS_PIN = WS_QD + (size_t)T * 512 * 2;
constexpr size_t WS_GT = WS_PIN + (size_t)T * 512 * 2;
constexpr size_t WS_SSQKV = WS_GT + (size_t)T * 6144 * 2;
constexpr size_t WS_SSQQ = WS_SSQKV + (size_t)T * 8 * 4;
constexpr size_t WS_KN = WS_SSQQ + al256((size_t)T * 12 * 4);
constexpr size_t WS_VM = WS_KN + (size_t)T * 1024 * 2;
constexpr size_t WS_QM = WS_VM + (size_t)T * 1024 * 2;
constexpr size_t WS_PL = WS_QM + (size_t)T * 1536 * 2;
constexpr size_t WS_OP = WS_PL + (size_t)T * 512 * 2;
constexpr size_t WS_OM = WS_OP + (size_t)T * 512 * 2;
constexpr size_t WS_OD = WS_OM + (size_t)T * 1024 * 2;
constexpr size_t WS_MG = WS_OD + (size_t)T * 512 * 2;
constexpr size_t WS_VB = WS_MG + (size_t)T * 2048 * 2;
constexpr size_t WS_TOPK = WS_VB + (size_t)T * 2048 * 2;
constexpr size_t WS_XG = WS_TOPK + (size_t)T * 32;
constexpr size_t WS_HB = WS_XG + (size_t)MAXSLOTS * 2048 * 2;
constexpr size_t WS_YB = WS_HB + (size_t)MAXSLOTS * 512 * 2;
constexpr size_t WS_VLO = WS_YB + (size_t)MAXSLOTS * 2048 * 2;
constexpr size_t WS_RP = WS_VLO + (size_t)T * 2048 * 2;
constexpr size_t WS_END = WS_RP + (size_t)6 * T * 80 * 4;

struct EpiIn {
    GC* wsb; const GF* bgate;
    __device__ __forceinline__ void operator()(AccRef acc, const Unit& u, int wr, int wc, int fr, int fq) const {
        unsigned wlo_ = (unsigned)(size_t)wsb, whi_ = (unsigned)((size_t)wsb >> 32); asm volatile("" : "+v"(wlo_), "+v"(whi_));
        GC* w_ = (GC*)(((size_t)(unsigned)__builtin_amdgcn_readfirstlane(whi_) << 32) | (size_t)(unsigned)__builtin_amdgcn_readfirstlane(wlo_));
        GB*CKV = (GB*)(w_ + WS_CKV), *KD = (GB*)(w_ + WS_KD), *VD = (GB*)(w_ + WS_VD), *KR = (GB*)(w_ + WS_KR), *CQ = (GB*)(w_ + WS_CQ), *QD = (GB*)(w_ + WS_QD), *PIN = (GB*)(w_ + WS_PIN), *GT = (GB*)(w_ + WS_GT);
        GF*SSQKV = (GF*)(w_ + WS_SSQKV), *SSQQ = (GF*)(w_ + WS_SSQQ); const GF*ropec = (const GF*)(w_ + WS_ROPE), *ropes = ropec + 1024;
        const int pn = u.pn, row0 = u.pm * 256 + wr * 64 + fr, cw = wc * 32 + 4 * fq, cw8 = wc * 32 + 8 * fq;
        const bool lat = u.pm < 32;
        if (pn < 2 || (pn >= 7 && pn < 10)) {
            const bool iskv = pn < 2; const int t0 = iskv ? pn : pn - 7; GB* dst = iskv ? CKV : CQ; const int ldd = iskv ? 512 : 768;
            GF* ssq = iskv ? SSQKV : SSQQ; const int nss = iskv ? 8 : 12;
#pragma unroll
            for (int ai = 0; ai < 2; ++ai)
#pragma unroll
                for (int m = 0; m < 4; ++m) { const int row = row0 + ai * 128 + m * 16; float s = 0.f;
#pragma unroll
                    for (int bj = 0; bj < 2; ++bj)
                        { const f32x4 v = acc[ai][bj][m][0], w = acc[ai][bj][m][1]; s += ((v[0] * v[0] + v[1] * v[1]) + (v[2] * v[2] + v[3] * v[3])) + ((w[0] * w[0] + w[1] * w[1]) + (w[2] * w[2] + w[3] * w[3]));
                            st8bf(dst + (size_t)row * ldd + t0 * 256 + bj * 128 + cw8, v, w); }
                    s += __shfl_xor(s, 16); s += __shfl_xor(s, 32);
                    if (fq == 0) ssq[(size_t)row * nss + t0 * 4 + wc] = s; }
        } else if (pn < 4 || pn == 6 || (pn >= 10 && pn < 12)) {
            if (pn == 6 && wc >= 2) return;
            const int half = wc & 1;
            GB* dst; int ldd, c0;
            if (pn < 4) { dst = KD; ldd = 512; c0 = (pn - 2) * 256; } else if (pn == 6) { dst = KR; ldd = 64; c0 = 0; } else { dst = QD; ldd = 512; c0 = (pn - 10) * 256; }
#pragma unroll
            for (int ai = 0; ai < 2; ++ai)
#pragma unroll
                for (int m = 0; m < 4; ++m) { const int row = row0 + ai * 128 + m * 16;
                    f32x4 cs = (f32x4){1.f, 1.f, 1.f, 1.f}, sn = (f32x4){0.f, 0.f, 0.f, 0.f};
                    if (lat) { const int t = row & 2047, pos = half ? (t & 63) : (t >> 6); cs = *(const Gf32x4*)(ropec + pos * 16 + 4 * fq); sn = *(const Gf32x4*)(ropes + pos * 16 + 4 * fq); }
#pragma unroll
                    for (int bj = 0; bj < 2; ++bj) { if (pn == 6 && bj == 1) continue;
                        const f32x4 x1 = acc[ai][bj][m][0], x2 = acc[ai][bj][m][1];
                        const f32x4 o1 = x1 * cs - x2 * sn, o2 = x2 * cs + x1 * sn;
                        GB* p = dst + (size_t)row * ldd + c0 + bj * 128 + cw;
                        st4bf(p, o1); st4bf(p + 16, o2); } }
        } else if (pn < 6 || pn < 14) {
            GB* dst = pn < 6 ? VD : PIN; const int c0 = (pn < 6 ? pn - 4 : pn - 12) * 256;
#pragma unroll
            for (int ai = 0; ai < 2; ++ai)
#pragma unroll
                for (int m = 0; m < 4; ++m) { const int row = row0 + ai * 128 + m * 16;
#pragma unroll
                    for (int bj = 0; bj < 2; ++bj) st8bf(dst + (size_t)row * 512 + c0 + bj * 128 + cw8, acc[ai][bj][m][0], acc[ai][bj][m][1]); }
        } else {
            const int c0 = (pn - 14) * 256;
            f32x4 bv[2][2];
#pragma unroll
            for (int bj = 0; bj < 2; ++bj)
#pragma unroll
                for (int n = 0; n < 2; ++n) bv[bj][n] = *(const Gf32x4*)(bgate + c0 + bj * 128 + cw8 + 4 * n);
#pragma unroll
            for (int ai = 0; ai < 2; ++ai)
#pragma unroll
                for (int m = 0; m < 4; ++m) { const int row = row0 + ai * 128 + m * 16;
#pragma unroll
                    for (int bj = 0; bj < 2; ++bj) { f32x4 v[2];
#pragma unroll
                        for (int n = 0; n < 2; ++n) { v[n] = acc[ai][bj][m][n] + bv[bj][n];
#pragma unroll
                            for (int j = 0; j < 4; ++j) v[n][j] = __builtin_amdgcn_rcpf(1.f + __builtin_amdgcn_exp2f(-LOG2E * v[n][j])); }
                        st8bf(GT + (size_t)row * 6144 + c0 + bj * 128 + cw8, v[0], v[1]); } }
        }
    }
};
struct EpiKV {
    GB*KN, *VM; const GF* SSQKV;
    __device__ __forceinline__ void operator()(AccRef acc, const Unit& u, int wr, int wc, int fr, int fq) const {
        const int row0 = u.pm * 256 + wr * 64 + fr, cw = wc * 32 + 8 * fq;
#pragma unroll
        for (int ai = 0; ai < 2; ++ai)
#pragma unroll
            for (int m = 0; m < 4; ++m) { const int row = row0 + ai * 128 + m * 16;
                const f32x4 s0 = *(const Gf32x4*)(SSQKV + (size_t)row * 8), s1 = *(const Gf32x4*)(SSQKV + (size_t)row * 8 + 4);
                const float ss = ((s0[0] + s0[1]) + (s0[2] + s0[3])) + ((s1[0] + s1[1]) + (s1[2] + s1[3]));
                const float r = 1.f / sqrtf(ss * (1.f / 512.f) + EPS);
                st8bf(KN + (size_t)row * 1024 + u.pn * 128 + cw, acc[ai][0][m][0] * r, acc[ai][0][m][1] * r); st8bf(VM + (size_t)row * 1024 + u.pn * 128 + cw, acc[ai][1][m][0] * r, acc[ai][1][m][1] * r); }
    }
};
struct EpiQ {
    GB* QM; const GF*SSQQ, *ropec, *ropes;
    __device__ __forceinline__ void operator()(AccRef acc, const Unit& u, int wr, int wc, int fr, int fq) const {
        const int row0 = u.pm * 256 + wr * 64 + fr; const bool lat = u.pm < 32;
#pragma unroll
        for (int ai = 0; ai < 2; ++ai)
#pragma unroll
            for (int m = 0; m < 4; ++m) { const int row = row0 + ai * 128 + m * 16;
                const f32x4 s0 = *(const Gf32x4*)(SSQQ + (size_t)row * 12), s1 = *(const Gf32x4*)(SSQQ + (size_t)row * 12 + 4), s2 = *(const Gf32x4*)(SSQQ + (size_t)row * 12 + 8);
                const float ss = ((s0[0] + s0[1]) + (s0[2] + s0[3])) + ((s1[0] + s1[1]) + (s1[2] + s1[3])) + ((s2[0] + s2[1]) + (s2[2] + s2[3]));
                const float r = 1.f / sqrtf(ss * (1.f / 768.f) + EPS);
#pragma unroll
                for (int bj = 0; bj < 2; ++bj) { const int cb = u.pn * 256 + bj * 128 + wc * 32, w0 = cb % 192;
                    f32x4 x1 = acc[ai][bj][m][0] * r, x2 = acc[ai][bj][m][1] * r;
                    if (w0 >= 128 && lat) { const int t = row & 2047, pos = (w0 >= 160) ? (t & 63) : (t >> 6);
                        const f32x4 cs = *(const Gf32x4*)(ropec + pos * 16 + 4 * fq), sn = *(const Gf32x4*)(ropes + pos * 16 + 4 * fq);
                        const f32x4 o1 = x1 * cs - x2 * sn, o2 = x2 * cs + x1 * sn; x1 = o1; x2 = o2; }
                    GB* p = QM + (size_t)row * 1536 + cb + 4 * fq; st4bf(p, x1); st4bf(p + 16, x2); } }
    }
};
struct EpiBf {
    GB* O; int ldc;
    __device__ __forceinline__ void operator()(AccRef acc, const Unit& u, int wr, int wc, int fr, int fq) const {
        const int row0 = u.pm * 256 + wr * 64 + fr, col0 = u.pn * 256 + wc * 32 + 8 * fq;
#pragma unroll
        for (int ai = 0; ai < 2; ++ai)
#pragma unroll
            for (int m = 0; m < 4; ++m) { GB* rp = O + (size_t)(row0 + ai * 128 + m * 16) * ldc + col0;
#pragma unroll
                for (int bj = 0; bj < 2; ++bj) st8bf(rp + bj * 128, acc[ai][bj][m][0], acc[ai][bj][m][1]); }
    }
};
template <int STEP> struct EpiMerge {
    GB* MG; const GB* GT; GU* flg; LAS unsigned* wcnt;
    __device__ __forceinline__ void operator()(AccRef acc, const Unit& u, int wr, int wc, int fr, int fq) const {
        const int row0 = u.pm * 256 + wr * 64 + fr, col0 = u.pn * 256 + wc * 32 + 8 * fq;
        if (STEP > 0 && u.ex > 0) {
            GU* f = flg + (STEP - 1) * 512 + (u.ex - 1); unsigned sp = 0u;
            while (__hip_atomic_load(f, __ATOMIC_RELAXED, __HIP_MEMORY_SCOPE_AGENT) < 8u) { __builtin_amdgcn_s_sleep(2); if (++sp > (1u << 24)) break; }
            __builtin_amdgcn_fence(__ATOMIC_ACQUIRE, "agent");
        }
#pragma unroll
        for (int ai = 0; ai < 2; ++ai)
#pragma unroll
            for (int m = 0; m < 4; ++m) { const int row = row0 + ai * 128 + m * 16;
#pragma unroll
                for (int bj = 0; bj < 2; ++bj) { const int col = col0 + bj * 128;
                        f32x4 g0, g1; ld8bf(GT + (size_t)row * 6144 + STEP * 2048 + col, g0, g1); f32x4 v0 = g0 * acc[ai][bj][m][0], v1 = g1 * acc[ai][bj][m][1];
                        GB* p = MG + (size_t)row * 2048 + col; if (STEP > 0) { f32x4 o0, o1; ld8bf(p, o0, o1); v0 = v0 + o0; v1 = v1 + o1; } st8bf(p, v0, v1); } }
        if (STEP < 2 && u.ex > 0) {
            asm volatile("s_waitcnt vmcnt(0)" ::: "memory");
            unsigned old = 0u; if ((fr | fq) == 0) old = __hip_atomic_fetch_add(wcnt, 1u, __ATOMIC_RELAXED, __HIP_MEMORY_SCOPE_WORKGROUP);
            old = (unsigned)__builtin_amdgcn_readfirstlane((int)old);
            if (old == 7u) {
                if ((fr | fq) == 0) __hip_atomic_store(wcnt, 0u, __ATOMIC_RELAXED, __HIP_MEMORY_SCOPE_WORKGROUP);
                __builtin_amdgcn_fence(__ATOMIC_RELEASE, "agent");
                if ((fr | fq) == 0) (void)__hip_atomic_fetch_add(flg + STEP * 512 + (u.ex - 1), 8u, __ATOMIC_RELAXED, __HIP_MEMORY_SCOPE_AGENT);
            }
        }
    }
};
struct EpiWo {
    GB* XS; const GF* modl; const GF* srcL; const GF* srcC; bool f32src;
    __device__ __forceinline__ void operator()(AccRef acc, const Unit& u, int wr, int wc, int fr, int fq) const {
        const int row0 = u.pm * 256 + wr * 64 + fr, col0 = u.pn * 256 + wc * 32 + 8 * fq;
        const int mrow = u.pm < 32 ? (u.pm >> 3) : 4; const GF* g1 = modl + (size_t)mrow * 12288 + 2 * 2048;
        f32x4 gv[2][2];
#pragma unroll
        for (int bj = 0; bj < 2; ++bj)
#pragma unroll
            for (int n = 0; n < 2; ++n) gv[bj][n] = *(const Gf32x4*)(g1 + col0 + bj * 128 + 4 * n);
#pragma unroll
        for (int ai = 0; ai < 2; ++ai)
#pragma unroll
            for (int m = 0; m < 4; ++m) { GB* rp = XS + (size_t)(row0 + ai * 128 + m * 16) * 2048 + col0; const GF* sp = (u.pm < 32 ? srcL : srcC) + (size_t)(row0 + ai * 128 + m * 16) * 2048 + col0;
#pragma unroll
                for (int bj = 0; bj < 2; ++bj) { GB* p = rp + bj * 128; f32x4 r0, r1;
                        if (f32src) { r0 = *(const Gf32x4*)(sp + bj * 128); r1 = *(const Gf32x4*)(sp + bj * 128 + 4); } else ld8bf(p, r0, r1);
                        st8bf(p, r0 * DN_ALPHA + gv[bj][0] * acc[ai][bj][m][0], r1 * DN_ALPHA + gv[bj][1] * acc[ai][bj][m][1]);
                    } }
    }
};
struct EpiGU {
    GB* HB;
    __device__ __forceinline__ void operator()(AccRef acc, const Unit& u, int wr, int wc, int fr, int fq) const {
        const int row0 = u.pm * 256 + wr * 64 + fr, col0 = u.pn * 128 + wc * 32 + 4 * fq;
#pragma unroll
        for (int ai = 0; ai < 2; ++ai)
#pragma unroll
            for (int m = 0; m < 4; ++m) { GB* rp = HB + (size_t)(row0 + ai * 128 + m * 16) * 512 + col0;
#pragma unroll
                for (int n = 0; n < 2; ++n) { const f32x4 gt = acc[ai][0][m][n], up = acc[ai][1][m][n]; f32x4 h;
#pragma unroll
                    for (int j = 0; j < 4; ++j) h[j] = gt[j] * __builtin_amdgcn_rcpf(1.f + __builtin_amdgcn_exp2f(-LOG2E * gt[j])) * up[j];
                    st4bf(rp + 16 * n, h); } }
    }
};


struct RouterP {
    const GB *VH, *VL, *WH, *WL; int K, lda, ldb; static constexpr int kstepB = 128;
    __device__ __forceinline__ const GAS char* aptr(const Unit& u) const { const int part = u.pn >> 1, half = u.pn & 1; return (const GAS char*)((part == 1 ? VL : VH) + (size_t)u.pm * 256 * 2048 + half * 1024); }
    __device__ __forceinline__ const GAS char* bptr(const Unit& u) const { const int part = u.pn >> 1, half = u.pn & 1; return (const GAS char*)((part == 2 ? WL : WH) + half * 1024); }
};
struct SliceOrder { int nM, G, c; __device__ bool next(int i, Unit& u) const { const int L = i * G + c; if (L >= nM * 6) return false; u.pm = L / 6; u.pn = L % 6; u.ex = 0; return true; } };
struct EpiRouter {
    GF* RP;
    __device__ __forceinline__ void operator()(AccRef acc, const Unit& u, int wr, int wc, int fr, int fq) const {
        if (wc >= 3) return;
        const int row0 = u.pm * 256 + wr * 64 + fr;
#pragma unroll
        for (int ai = 0; ai < 2; ++ai)
#pragma unroll
            for (int m = 0; m < 4; ++m) { GF* rp = RP + ((size_t)u.pn * T + row0 + ai * 128 + m * 16) * 80 + wc * 32 + 4 * fq;
#pragma unroll
                for (int n = 0; n < 2; ++n) if (wc * 32 + 16 * n + 4 * fq < 72) *(Gf32x4*)(rp + 16 * n) = acc[ai][0][m][n]; }
    }
};

namespace mg {
constexpr int A_OFF = 0, A_BUF = 49152, B_OFF = 98304, B_BUF = 16384;
__device__ __forceinline__ int swz(int row, int ch) { return row * 128 + ((ch ^ (row & 7)) << 4); }
__device__ __forceinline__ int swzb(int row, int ch) { return row * 128 + ((ch ^ ((((row >> 1) ^ (row >> 4)) & 1) | (((row >> 2) & 3) << 1))) << 4); }
constexpr int TAB_OFF = 135168;
template <int MODE>
__device__ __forceinline__ void moe_gemm(LAS unsigned char* lds, const GB* A, const GF* Wl, GB* O, const GI* ts, const GI* tv, const GI* s2t, int nst, int G, int c) {
    constexpr int K = MODE == 0 ? 2048 : 512, LDW = MODE == 0 ? 1024 : 2048, LDA = K, NPT = MODE == 0 ? 8 : 16, NKT = K / 64;
    int tid_ = threadIdx.x; asm volatile("" : "+v"(tid_));
    const int tid = tid_, wid = __builtin_amdgcn_readfirstlane(tid >> 6), lane = tid & 63, fr = lane & 15, fq = lane >> 4;
    LAS int* tab = (LAS int*)(lds + TAB_OFF);
    if (tid < 128) { const bool in = tid < nst; tab[tid] = in ? __hip_atomic_load(ts + tid, __ATOMIC_RELAXED, __HIP_MEMORY_SCOPE_AGENT) : 0;
        tab[128 + tid] = in ? __hip_atomic_load(tv + tid, __ATOMIC_RELAXED, __HIP_MEMORY_SCOPE_AGENT) : 0; }
    __syncthreads();
    const int tpr = G / NPT;
    int tl, pt;
    if ((G & 7) == 0 && (tpr & 7) == 0) { const int x = c & 7, sl = c >> 3; tl = x * (tpr >> 3) + sl / NPT; pt = sl % NPT; } else { tl = c / NPT; pt = c % NPT; if (tl >= tpr) tl = nst; }
    const int n4 = tid & 31, k4 = tid >> 5;
    const int nbl = 32 * (n4 >> 3) + 16 * (n4 & 1) + 4 * ((n4 >> 1) & 3);
    const int nb = 4 * n4, bcol = MODE == 0 ? (nb < 64 ? 64 * pt + nb : 512 + 64 * pt + (nb - 64)) : 128 * pt + nb;
    if (tl < nst) {
        int st = tl, e = __builtin_amdgcn_readfirstlane(tab[st]), tvc = __builtin_amdgcn_readfirstlane(tab[128 + st]), ngrp = (tvc + 63) >> 6;
        const GF* W = Wl + (size_t)e * K * LDW; const GB* Ab = A + (size_t)st * 512 * LDA;
        f32x4 acc[3][8];
#pragma unroll
        for (int m = 0; m < 3; ++m)
#pragma unroll
            for (int n = 0; n < 8; ++n) acc[m][n] = (f32x4){0.f, 0.f, 0.f, 0.f};
        f32x4 pb0[4], pb1[4];
#pragma unroll
        for (int q = 0; q < 4; ++q) { pb0[q] = (f32x4){0.f, 0.f, 0.f, 0.f}; pb1[q] = (f32x4){0.f, 0.f, 0.f, 0.f}; }
        unsigned voa = (unsigned)((tid >> 3) * LDA + 8 * ((tid & 7) ^ ((tid >> 3) & 7))) * 2u, vob = (unsigned)(4 * k4 * LDW + bcol) * 4u;
        asm volatile("" : "+v"(voa), "+v"(vob));
        const unsigned ldsw = (unsigned)wid * 1024u;
        const unsigned choff = 16u * (unsigned)((tid & 7) ^ ((tid >> 3) & 7)); unsigned vot = (unsigned)(tid >> 3) * 4u; asm volatile("" : "+v"(vot));
        unsigned voa6[6] = {0u, 0u, 0u, 0u, 0u, 0u}, voa6n[6] = {0u, 0u, 0u, 0u, 0u, 0u};
#define MG_LDT(dst6, stX) do { _Pragma("unroll") for (int i = 0; i < 6; ++i) asm volatile("global_load_dword %0, %1, %2" : "+v"(dst6[i]) : "v"(vot + (unsigned)(i * 256)), "s"((const GAS char*)(s2t + (size_t)(stX) * 512)) : "memory"); } while (0)
#define MG_TOK(dst6, tvX) do { _Pragma("unroll") for (int i = 0; i < 6; ++i) dst6[i] = ((tid >> 3) + 64 * i < (tvX) ? dst6[i] : 0u) * 4096u + choff; } while (0)
#define MG_LDA0(cb, VO, ng_, kt) do { _Pragma("unroll") for (int i = 0; i < 6; ++i) \
            __builtin_amdgcn_global_load_lds((const unsigned*)((const GAS char*)(A + (kt) * 64) + VO[i]), (LAS unsigned*)(lds + A_OFF + (cb) * A_BUF + i * 8192 + ldsw), 16, 0, 0); } while (0)
#define MG_GLD(dst, voff, base) asm volatile("global_load_dwordx4 %0, %1, %2" : "+v"(dst) : "v"(voff), "s"(base) : "memory")
#define MG_LDA(cb, Ab_, ng_, kt) do { _Pragma("unroll") for (int i = 0; i < 6; ++i) \
            __builtin_amdgcn_global_load_lds((const unsigned*)((const GAS char*)((Ab_) + (size_t)(i < (ng_) ? i : 0) * 64 * LDA + (kt) * 64) + voa), (LAS unsigned*)(lds + A_OFF + (cb) * A_BUF + i * 8192 + ldsw), 16, 0, 0); } while (0)
#define MG_LDB(W_, kt, P) do { _Pragma("unroll") for (int q = 0; q < 4; ++q) MG_GLD(P[q], vob, (const GAS char*)((W_) + (size_t)((kt) * 64 + q) * LDW)); } while (0)
#define MG_WAIT(P, N) asm volatile("s_waitcnt vmcnt(" #N ")" : "+v"(P[0]), "+v"(P[1]), "+v"(P[2]), "+v"(P[3]) :: "memory")
#define MG_ITER(cb, P, NW, LOADS) do { \
            MG_WAIT(P, NW); \
            _Pragma("unroll") for (int j = 0; j < 4; ++j) { u32x2 w; w.x = cvt_pk_bf16(P[0][j], P[1][j]); w.y = cvt_pk_bf16(P[2][j], P[3][j]); \
                *(LAS u32x2*)(lds + B_OFF + cb * B_BUF + swzb(nbl + j, k4 >> 1) + (k4 & 1) * 8) = w; } \
            asm volatile("s_waitcnt lgkmcnt(0)" ::: "memory"); __builtin_amdgcn_s_barrier();     \
            LOADS;                                                       \
            _Pragma("unroll") for (int ks = 0; ks < 2; ++ks) { \
                bf16x8 Af[3]; \
                _Pragma("unroll") for (int m = 0; m < 3; ++m) Af[m] = *(const LAS bf16x8*)(lds + A_OFF + cb * A_BUF + swz(wid * 48 + m * 16 + fr, ks * 4 + fq)); \
                _Pragma("unroll") for (int nh = 0; nh < 4; ++nh) { \
                    bf16x8 Bf[2]; \
                    _Pragma("unroll") for (int n = 0; n < 2; ++n) Bf[n] = *(const LAS bf16x8*)(lds + B_OFF + cb * B_BUF + swzb((nh * 2 + n) * 16 + fr, ks * 4 + fq)); \
                    _Pragma("unroll") for (int m = 0; m < 3; ++m) \
                        _Pragma("unroll") for (int n = 0; n < 2; ++n) acc[m][nh * 2 + n] = __builtin_amdgcn_mfma_f32_16x16x32_bf16(Bf[n], Af[m], acc[m][nh * 2 + n], 0, 0, 0); \
                } \
            } } while (0)
        if constexpr (MODE == 0) {
            MG_LDT(voa6, st); asm volatile("s_waitcnt vmcnt(0)" : "+v"(voa6[0]), "+v"(voa6[1]), "+v"(voa6[2]), "+v"(voa6[3]), "+v"(voa6[4]), "+v"(voa6[5]) :: "memory"); MG_TOK(voa6, tvc);
            MG_LDB(W, 0, pb0); MG_LDA0(0, voa6, ngrp, 0); MG_LDB(W, 1, pb1);
        } else { MG_LDB(W, 0, pb0); MG_LDA(0, Ab, ngrp, 0); MG_LDB(W, 1, pb1); }
        for (;;) {
            const int stn = st + tpr; const bool more = stn < nst; const int sn = more ? stn : st;
            const int en = __builtin_amdgcn_readfirstlane(tab[sn]), tvn = __builtin_amdgcn_readfirstlane(tab[128 + sn]), ngn = (tvn + 63) >> 6;
            const GF* Wn = Wl + (size_t)en * K * LDW; const GB* Abn = A + (size_t)sn * 512 * LDA;
            if constexpr (MODE == 0) {
                MG_LDT(voa6n, sn);
                { const GF* Wa = W + (size_t)2 * 64 * LDW;
                  MG_ITER(0, pb0, 10, MG_LDA0(1, voa6, ngrp, 1); MG_LDB(Wa, 0, pb0));
                  MG_ITER(1, pb1, 4, MG_LDA0(0, voa6, ngrp, 2); MG_LDB(Wa, 1, pb1)); }
                asm volatile("" : "+v"(voa6n[0]), "+v"(voa6n[1]), "+v"(voa6n[2]), "+v"(voa6n[3]), "+v"(voa6n[4]), "+v"(voa6n[5]));
                MG_TOK(voa6n, tvn);
                for (int kt = 2; kt < NKT - 2; kt += 2) {
                    const GF* Wa = W + (size_t)(kt + 2) * 64 * LDW;
                    MG_ITER(0, pb0, 4, MG_LDA0(1, voa6, ngrp, kt + 1); MG_LDB(Wa, 0, pb0));
                    MG_ITER(1, pb1, 4, MG_LDA0(0, voa6, ngrp, kt + 2); MG_LDB(Wa, 1, pb1));
                }
                MG_ITER(0, pb0, 4, MG_LDA0(1, voa6, ngrp, NKT - 1); MG_LDB(Wn, 0, pb0));
                MG_ITER(1, pb1, 4, MG_LDA0(0, voa6n, ngn, 0); MG_LDB(Wn, 1, pb1));
            } else {
                for (int kt = 0; kt < NKT; kt += 2) {
                    const bool tail = kt + 2 >= NKT;
                    const GF* Wa = tail ? Wn : W + (size_t)(kt + 2) * 64 * LDW; const GB* Aa = tail ? Abn : Ab + (kt + 2) * 64; const int nga = tail ? ngn : ngrp;
                    MG_ITER(0, pb0, 4, MG_LDA(1, Ab, ngrp, kt + 1); MG_LDB(Wa, 0, pb0));
                    MG_ITER(1, pb1, 4, MG_LDA(0, Aa, nga, 0); MG_LDB(Wa, 1, pb1));
                }
            }
            const int row0 = st * 512 + wid * 48 + fr;
            if (MODE == 0) {
#pragma unroll
                for (int m = 0; m < 3; ++m)
#pragma unroll
                    for (int tp = 0; tp < 2; ++tp) { f32x4 h[2];
#pragma unroll
                        for (int a = 0; a < 2; ++a) { const f32x4 gt = acc[m][2 * tp + a], up = acc[m][2 * tp + a + 4];
#pragma unroll
                            for (int j = 0; j < 4; ++j) h[a][j] = gt[j] * __builtin_amdgcn_rcpf(1.f + __builtin_amdgcn_exp2f(-LOG2E * gt[j])) * up[j]; }
                        st8bf(O + (size_t)(row0 + m * 16) * 512 + 64 * pt + 32 * tp + 8 * fq, h[0], h[1]); }
            } else {
#pragma unroll
                for (int m = 0; m < 3; ++m)
#pragma unroll
                    for (int tp = 0; tp < 4; ++tp) st8bf(O + (size_t)(row0 + m * 16) * 2048 + 128 * pt + 32 * tp + 8 * fq, acc[m][2 * tp], acc[m][2 * tp + 1]);
            }
            if (!more) break;
#pragma unroll
            for (int m = 0; m < 3; ++m)
#pragma unroll
                for (int n = 0; n < 8; ++n) acc[m][n] = (f32x4){0.f, 0.f, 0.f, 0.f};
            st = stn; W = Wn; Ab = Abn; ngrp = ngn;
#pragma unroll
            for (int i = 0; i < 6; ++i) voa6[i] = voa6n[i];
        }
        asm volatile("s_waitcnt vmcnt(0)" : "+v"(pb0[0]), "+v"(pb0[1]), "+v"(pb0[2]), "+v"(pb0[3]), "+v"(pb1[0]), "+v"(pb1[1]), "+v"(pb1[2]), "+v"(pb1[3]) :: "memory");
#undef MG_ITER
#undef MG_LDA0
#undef MG_TOK
#undef MG_LDT
#undef MG_WAIT
#undef MG_LDB
#undef MG_LDA
#undef MG_GLD
    }
    __syncthreads();
}
}

namespace att {
constexpr int KVBLK = 64;
constexpr int SHM_V = KVBLK * 128 * 2, SHM_K = KVBLK * 128 * 2, SHM_R = KVBLK * 64 * 2;
constexpr int OFF_V = 0, OFF_K = 2 * SHM_V, OFF_R = OFF_K + 2 * SHM_K, OFF_WS = OFF_R + 2 * SHM_R, ATT_LDS = OFF_WS + 8 * 64 * 4;
constexpr float THR2 = 8.f * LOG2E;
#define KSWZ(row, colB) ((row) * 256 + ((colB) ^ (((row) & 7) << 4)))
#define SBAR() __builtin_amdgcn_sched_barrier(0)
__device__ __forceinline__ int crow(int r, int hi) { return (r & 3) + 8 * (r >> 2) + 4 * hi; }
__device__ __forceinline__ void partialSM(f32x16& p0, f32x16& p1, float& m_reg, float& alpha) {
    float pmax = p0[0];
#pragma unroll
    for (int r = 1; r < 16; ++r) pmax = fmaxf(pmax, p0[r]);
#pragma unroll
    for (int r = 0; r < 16; ++r) pmax = fmaxf(pmax, p1[r]);
    { auto rr = __builtin_amdgcn_permlane32_swap(__float_as_uint(pmax), __float_as_uint(pmax), false, false); pmax = fmaxf(__uint_as_float(rr[0]), __uint_as_float(rr[1])); }
    float mn;
    if (__builtin_expect(__all(pmax - m_reg <= THR2), 1)) { mn = m_reg; alpha = 1.f; }
    else { mn = fmaxf(m_reg, pmax); alpha = __builtin_amdgcn_exp2f(m_reg - mn); m_reg = mn; }
#pragma unroll
    for (int r = 0; r < 16; ++r) p0[r] = p0[r] - mn;
#pragma unroll
    for (int r = 0; r < 16; ++r) p1[r] = p1[r] - mn;
#pragma unroll
    for (int r = 0; r < 16; ++r) p0[r] = __builtin_amdgcn_exp2f(p0[r]);
}
__device__ __forceinline__ void finishSM(f32x16& p0, f32x16& p1, float alpha, float& l_reg, bf16x8& pa0, bf16x8& pa1, bf16x8& pa2, bf16x8& pa3) {
#pragma unroll
    for (int r = 0; r < 16; ++r) p1[r] = __builtin_amdgcn_exp2f(p1[r]);
    float ps = 0;
#pragma unroll
    for (int r = 0; r < 16; ++r) ps += p0[r];
#pragma unroll
    for (int r = 0; r < 16; ++r) ps += p1[r];
    { auto rr = __builtin_amdgcn_permlane32_swap(__float_as_uint(ps), __float_as_uint(ps), false, false); ps = __uint_as_float(rr[0]) + __uint_as_float(rr[1]); }
    l_reg = l_reg * alpha + ps;
#define PK4(P, BASE, OUT) do { unsigned a0 = cvt_pk_bf16(P[BASE + 0], P[BASE + 1]), a1 = cvt_pk_bf16(P[BASE + 2], P[BASE + 3]);   \
    unsigned b0 = cvt_pk_bf16(P[BASE + 4], P[BASE + 5]), b1 = cvt_pk_bf16(P[BASE + 6], P[BASE + 7]);                              \
    auto r0 = __builtin_amdgcn_permlane32_swap(a0, b0, false, false); auto r1 = __builtin_amdgcn_permlane32_swap(a1, b1, false, false); \
    u32x4 w = {r0[0], r1[0], r0[1], r1[1]}; OUT = __builtin_bit_cast(bf16x8, w); } while (0)
    PK4(p0, 0, pa0); PK4(p0, 8, pa1); PK4(p1, 0, pa2); PK4(p1, 8, pa3);
#undef PK4
}
__device__ __forceinline__ int v_st(int k, int c) { const int kk = (k & ~0xC) | ((k & 4) << 1) | ((k & 8) >> 1); return ((kk >> 3) * 4 + (c >> 5)) * 512 + ((kk & 7) * 32 + (c & 31)) * 2; }
__device__ __forceinline__ int v_rd_base(int lane) { return ((lane & 3) << 3) | (((lane >> 2) & 3) << 6) | (((lane >> 4) & 1) << 5) | (((lane >> 5) & 1) << 8); }
constexpr int v_rd_off(int d0, int ks, int half) { return d0 * 512 + ks * 4096 + half * 2048; }
template <int OFF> __device__ __forceinline__ s16x4 tr_read(unsigned vb) { s16x4 r; asm volatile("ds_read_b64_tr_b16 %0, %1 offset:%2" : "=&v"(r) : "v"(vb), "i"(OFF) : "memory"); return r; }
#define PV_SET(S, D0) const s16x4 S##l0 = tr_read<v_rd_off(D0, 0, 0)>(vb), S##h0 = tr_read<v_rd_off(D0, 0, 1)>(vb), S##l1 = tr_read<v_rd_off(D0, 1, 0)>(vb), S##h1 = tr_read<v_rd_off(D0, 1, 1)>(vb), \
    S##l2 = tr_read<v_rd_off(D0, 2, 0)>(vb), S##h2 = tr_read<v_rd_off(D0, 2, 1)>(vb), S##l3 = tr_read<v_rd_off(D0, 3, 0)>(vb), S##h3 = tr_read<v_rd_off(D0, 3, 1)>(vb)
#define PV_PK(L, H) (bf16x8){L[0], L[1], L[2], L[3], H[0], H[1], H[2], H[3]}
#define PV_MMA(od, S) do { od = __builtin_amdgcn_mfma_f32_32x32x16_bf16(pa0, PV_PK(S##l0, S##h0), od, 0, 0, 0); od = __builtin_amdgcn_mfma_f32_32x32x16_bf16(pa1, PV_PK(S##l1, S##h1), od, 0, 0, 0); \
    od = __builtin_amdgcn_mfma_f32_32x32x16_bf16(pa2, PV_PK(S##l2, S##h2), od, 0, 0, 0); od = __builtin_amdgcn_mfma_f32_32x32x16_bf16(pa3, PV_PK(S##l3, S##h3), od, 0, 0, 0); } while (0)
__device__ __forceinline__ void pv_d0(f32x16* o, unsigned vb, bf16x8 pa0, bf16x8 pa1, bf16x8 pa2, bf16x8 pa3) {
    PV_SET(a, 0);
    PV_SET(b, 1); asm volatile("s_waitcnt lgkmcnt(8)" ::: "memory"); SBAR(); PV_MMA(o[0], a); SBAR();
    PV_SET(c, 2); asm volatile("s_waitcnt lgkmcnt(8)" ::: "memory"); SBAR(); PV_MMA(o[1], b); SBAR();
    PV_SET(d, 3); asm volatile("s_waitcnt lgkmcnt(8)" ::: "memory"); SBAR(); PV_MMA(o[2], c); SBAR();
    asm volatile("s_waitcnt lgkmcnt(0)" ::: "memory"); SBAR(); PV_MMA(o[3], d);
}
#undef PV_MMA
#undef PV_PK
#undef PV_SET

struct Args {
    const GB*Q, *K, *V, *KR; GB* O;
    int ldq, ldk, ldo, qcol, kcol, ocol;
    int qrow0;
    int nt_ctx, nt, ctx_row0, lat_row0;
    float lamv, osc; const GF* gsub;
};

template <int MODE>
__device__ __forceinline__ void attn_unit(const Args& a, LAS unsigned char* lds) {
    constexpr int NKS = MODE == 0 ? 12 : 4;
    int tid_ = threadIdx.x; asm volatile("" : "+v"(tid_));
    const int tid = tid_, wid = __builtin_amdgcn_readfirstlane(tid >> 6), lane = tid & 63, r32 = lane & 31, hi = lane >> 5;
    const int grp = MODE == 1 ? (wid >> 2) : 0, wq = MODE == 1 ? (wid & 3) : wid;
    LAS unsigned char* V_lds = lds + OFF_V; LAS unsigned char* K_lds = lds + OFF_K; LAS unsigned char* R_lds = lds + OFF_R;
    LAS float* ws = (LAS float*)(lds + OFF_WS) + wid * 64; LAS float* li_l = ws; LAS float* al_l = ws + 32;
    float m_reg = -1e30f, l_reg = 0; f32x16 o[4] = {}; bf16x8 qr[NKS];
    {
        const GB* Qw = a.Q + (size_t)(a.qrow0 + wq * 32 + r32) * a.ldq + a.qcol + (MODE == 1 ? grp * 64 : 0) + hi * 8;
#pragma unroll
        for (int d0 = 0; d0 < NKS; ++d0) qr[d0] = *(const Gbf16x8*)(Qw + d0 * 16);
    }
    const int sr = tid >> 4, sc = (tid & 15) * 8, vst0 = v_st(sr, sc), vst1 = v_st(32 + sr, sc);
    const int rr = tid >> 3, rc = (tid & 7) * 8, rst = KSWZ(rr & 31, ((rr >> 5) * 64 + rc) * 2);
    const unsigned vb0 = (unsigned)(size_t)V_lds + v_rd_base(lane);
    const GB* Kg = a.K + a.kcol + sc; const GB* Vg = a.V + a.kcol + sc; const GB* Rg = a.KR + rc;
    bf16x8 svs0, svs1, sks0, sks1, skr;
#define KROW(j) ((j) < a.nt_ctx ? a.ctx_row0 + 64 * (j) : a.lat_row0 + 64 * ((j) - a.nt_ctx))
#define SLOAD(j) do { const int k0_ = KROW(j); svs0 = *(const Gbf16x8*)(Vg + (size_t)(k0_ + sr) * a.ldk); svs1 = *(const Gbf16x8*)(Vg + (size_t)(k0_ + 32 + sr) * a.ldk); \
    sks0 = *(const Gbf16x8*)(Kg + (size_t)(k0_ + sr) * a.ldk); sks1 = *(const Gbf16x8*)(Kg + (size_t)(k0_ + 32 + sr) * a.ldk); \
    if (MODE == 0) skr = *(const Gbf16x8*)(Rg + (size_t)(k0_ + rr) * 64); } while (0)
#define SWRITE(b) do { *(LAS bf16x8*)(V_lds + (b) * SHM_V + vst0) = svs0; *(LAS bf16x8*)(V_lds + (b) * SHM_V + vst1) = svs1; const int kc = sc * 2; \
    *(LAS bf16x8*)(K_lds + (b) * SHM_K + KSWZ(sr, kc)) = sks0; *(LAS bf16x8*)(K_lds + (b) * SHM_K + KSWZ(32 + sr, kc)) = sks1; \
    if (MODE == 0) *(LAS bf16x8*)(R_lds + (b) * SHM_R + rst) = skr; } while (0)
#define RESC(al) do { if (__any((al) < 1.f)) { if (hi == 0) al_l[r32] = (al); asm volatile("s_waitcnt lgkmcnt(0)" ::: "memory"); \
    _Pragma("unroll") for (int d = 0; d < 4; ++d) _Pragma("unroll") for (int r = 0; r < 16; ++r) o[d][r] *= al_l[crow(r, hi)]; } } while (0)
#define QKT(P0, P1, b) do { P0 = f32x16{}; P1 = f32x16{}; \
    if (MODE == 0) { \
        _Pragma("unroll") for (int d0 = 0; d0 < 8; ++d0) { const int cb = (d0 * 16 + hi * 8) * 2; \
            const bf16x8 b0 = *(const LAS bf16x8*)(K_lds + (b) * SHM_K + KSWZ(r32, cb)), b1 = *(const LAS bf16x8*)(K_lds + (b) * SHM_K + KSWZ(32 + r32, cb)); \
            P0 = __builtin_amdgcn_mfma_f32_32x32x16_bf16(b0, qr[d0], P0, 0, 0, 0); P1 = __builtin_amdgcn_mfma_f32_32x32x16_bf16(b1, qr[d0], P1, 0, 0, 0); } \
        _Pragma("unroll") for (int d0 = 0; d0 < 4; ++d0) { const int cb = (d0 * 16 + hi * 8) * 2; \
            const bf16x8 b0 = *(const LAS bf16x8*)(R_lds + (b) * SHM_R + KSWZ(r32, cb)), b1 = *(const LAS bf16x8*)(R_lds + (b) * SHM_R + KSWZ(r32, 128 + cb)); \
            P0 = __builtin_amdgcn_mfma_f32_32x32x16_bf16(b0, qr[8 + d0 < NKS ? 8 + d0 : 0], P0, 0, 0, 0); P1 = __builtin_amdgcn_mfma_f32_32x32x16_bf16(b1, qr[8 + d0 < NKS ? 8 + d0 : 0], P1, 0, 0, 0); } \
    } else { \
        _Pragma("unroll") for (int d0 = 0; d0 < 4; ++d0) { const int cb = (grp * 64 + d0 * 16 + hi * 8) * 2; \
            const bf16x8 b0 = *(const LAS bf16x8*)(K_lds + (b) * SHM_K + KSWZ(r32, cb)), b1 = *(const LAS bf16x8*)(K_lds + (b) * SHM_K + KSWZ(32 + r32, cb)); \
            P0 = __builtin_amdgcn_mfma_f32_32x32x16_bf16(b0, qr[d0], P0, 0, 0, 0); P1 = __builtin_amdgcn_mfma_f32_32x32x16_bf16(b1, qr[d0], P1, 0, 0, 0); } \
    } } while (0)
    f32x16 p0, p1; float al; bf16x8 pa0, pa1, pa2, pa3; const int NT = a.nt;
    SLOAD(0); asm volatile("s_waitcnt vmcnt(0)" ::: "memory"); SWRITE(0); __syncthreads();
    for (int j = 0; j < NT; ++j) {
        const int cur = j & 1; const bool more = j + 1 < NT;
        if (more) SLOAD(j + 1);
        SBAR(); QKT(p0, p1, cur);
        partialSM(p0, p1, m_reg, al);
        finishSM(p0, p1, al, l_reg, pa0, pa1, pa2, pa3); SBAR();
        RESC(al);
        pv_d0(o, vb0 + cur * SHM_V, pa0, pa1, pa2, pa3);
        if (more) { asm volatile("s_waitcnt vmcnt(0)" ::: "memory"); SWRITE(cur ^ 1); }
        __syncthreads();
    }
    if (hi == 0) li_l[r32] = l_reg; asm volatile("s_waitcnt lgkmcnt(0)" ::: "memory");
    float rli[16];
#pragma unroll
    for (int r = 0; r < 16; ++r) rli[r] = __builtin_amdgcn_rcpf(li_l[crow(r, hi)]);
    if (MODE == 0) {
        GB* Ow = a.O + (size_t)(a.qrow0 + wq * 32) * a.ldo + a.ocol;
#pragma unroll
        for (int r = 0; r < 16; ++r) { const int orow = crow(r, hi);
#pragma unroll
            for (int d0 = 0; d0 < 4; ++d0) Ow[(size_t)orow * a.ldo + d0 * 32 + r32] = (bf16_t)f2bf(o[d0][r] * rli[r]); }
        __syncthreads();
    } else {
        __syncthreads();
        LAS float* stash = (LAS float*)lds;
        if (grp == 1) {
#pragma unroll
            for (int d0 = 0; d0 < 4; ++d0)
#pragma unroll
                for (int r = 0; r < 16; ++r) stash[((wq * 4 + d0) * 16 + r) * 64 + lane] = o[d0][r] * rli[r];
        }
        __syncthreads();
        if (grp == 0) {
            float ss[16];
#pragma unroll
            for (int r = 0; r < 16; ++r) { ss[r] = 0.f;
#pragma unroll
                for (int d0 = 0; d0 < 4; ++d0) { const float x = o[d0][r] * rli[r] - a.lamv * stash[((wq * 4 + d0) * 16 + r) * 64 + lane]; o[d0][r] = x; ss[r] += x * x; } }
#pragma unroll
            for (int r = 0; r < 16; ++r) {
#pragma unroll
                for (int of = 1; of < 32; of <<= 1) ss[r] += __shfl_xor(ss[r], of);
                ss[r] = a.osc / sqrtf(ss[r] * (1.f / 128.f) + EPS); }
            float gs[4];
#pragma unroll
            for (int d0 = 0; d0 < 4; ++d0) gs[d0] = a.gsub[d0 * 32 + r32];
            GB* Ow = a.O + (size_t)(a.qrow0 + wq * 32) * a.ldo + a.ocol;
#pragma unroll
            for (int r = 0; r < 16; ++r) { const int orow = crow(r, hi);
#pragma unroll
                for (int d0 = 0; d0 < 4; ++d0) Ow[(size_t)orow * a.ldo + d0 * 32 + r32] = (bf16_t)f2bf(o[d0][r] * ss[r] * gs[d0]); }
        }
        __syncthreads();
    }
#undef KROW
#undef SLOAD
#undef SWRITE
#undef RESC
#undef QKT
}
}

#define XB_TMO      128
#define XB_XCNT(j)  (256  + 64 * (j))
#define XB_XSUB(j)  (1280 + 64 * (j))
#define XB_XGEN(j)  (2304 + 64 * (j))
#define XB_TOP      3328
#define XB_TOPGEN   3392
#define XCD_BAR_WORDS 3456
#define XB_SPIN_CAP (1u << 22)
__device__ __forceinline__ unsigned xb_ld(unsigned* p)              { return __hip_atomic_load(p, __ATOMIC_RELAXED, __HIP_MEMORY_SCOPE_AGENT); }
__device__ __forceinline__ unsigned xb_add(unsigned* p, unsigned v) { return __hip_atomic_fetch_add(p, v, __ATOMIC_RELAXED, __HIP_MEMORY_SCOPE_AGENT); }
__device__ __forceinline__ unsigned xb_xcc_id() { return (unsigned)__builtin_amdgcn_s_getreg((3 << 11) | 20) & 0xFu; }
#define XB_SPIN(cond, bar) do { unsigned _sp = 0; while (cond) { __builtin_amdgcn_s_sleep(1); \
    if ((++_sp & 255u) == 0u) { if (xb_ld(&(bar)[XB_TMO])) break; if (_sp > XB_SPIN_CAP) { atomicAdd(&(bar)[XB_TMO], 1u); break; } } } } while (0)
struct XcdBarrier { unsigned* bar; unsigned x; volatile LAS unsigned* st; };
__device__ __forceinline__ XcdBarrier xcd_barrier_post(unsigned* bar, volatile LAS unsigned* st) {
    XcdBarrier b; b.bar = bar; b.x = xb_xcc_id(); b.st = st;
    if (threadIdx.x == 0) (void)xb_add(&bar[XB_XCNT(b.x)], 1u);
    return b;
}
__device__ __forceinline__ void xcd_barrier_complete(unsigned* bar, unsigned x, unsigned& nloc, unsigned& nx) {
    const unsigned G = gridDim.x * gridDim.y * gridDim.z;
    unsigned sum, cnt, mine, sp = 0u;
    for (;;) {
        sum = 0u; cnt = 0u; mine = 0u;
#pragma unroll
        for (unsigned j = 0; j < 16; ++j) { const unsigned c = xb_ld(&bar[XB_XCNT(j)]); sum += c; cnt += (c > 0u) ? 1u : 0u; mine = (j == x) ? c : mine; }
        if (sum == G) break;
        __builtin_amdgcn_s_sleep(1);
        if ((++sp & 255u) == 0u) { if (xb_ld(&bar[XB_TMO])) break; if (sp > XB_SPIN_CAP) { atomicAdd(&bar[XB_TMO], 1u); break; } }
    }
    nloc = mine > 0u ? mine : 1u; nx = cnt > 0u ? cnt : 1u;
}
__device__ __forceinline__ void xcd_barrier(const XcdBarrier& b) {
    asm volatile("s_waitcnt vmcnt(0)" ::: "memory");
    __syncthreads();
    if (threadIdx.x == 0) {
        unsigned* bar = b.bar;
        __builtin_amdgcn_s_waitcnt(0);
        unsigned nloc = b.st[0], nx = b.st[1];
        if (nloc == 0u) { xcd_barrier_complete(bar, b.x, nloc, nx); b.st[0] = nloc; b.st[1] = nx; }
        const unsigned old = xb_add(&bar[XB_XSUB(b.x)], 1u);
        const unsigned gen = old / nloc;
        if (old + 1u == (gen + 1u) * nloc) {
            __builtin_amdgcn_fence(__ATOMIC_RELEASE, "agent");
            asm volatile("s_waitcnt vmcnt(0)" ::: "memory");
            const unsigned og = xb_add(&bar[XB_TOP], 1u);
            const unsigned tg = og / nx;
            if (og + 1u == (tg + 1u) * nx) xb_add(&bar[XB_TOPGEN], 1u);
            else XB_SPIN(xb_ld(&bar[XB_TOPGEN]) == tg, bar);
            __builtin_amdgcn_fence(__ATOMIC_ACQUIRE, "agent");
            xb_add(&bar[XB_XGEN(b.x)], 1u);
            asm volatile("s_waitcnt vmcnt(0)" ::: "memory");
        } else {
            XB_SPIN(xb_ld(&bar[XB_XGEN(b.x)]) == gen, bar);
            __builtin_amdgcn_fence(__ATOMIC_ACQUIRE, "agent");
            asm volatile("s_waitcnt vmcnt(0)" ::: "memory");
        }
    }
    __syncthreads();
}

constexpr int NWAVES = 8;
constexpr int RING_BYTES = 131072, LDSCTL_OFF = RING_BYTES, MISC_OFF = LDSCTL_OFF + 320, LDS_BYTES = 147456;
constexpr int NPHASE = 2 + 10 * NL;

struct Args {
    const float* in[30]; float* out; unsigned char* ws; int ph_lo, ph_hi, region, pad;
};

__device__ __forceinline__ void cvt_item(const GF* W, int ldw, int k0, int n0, GB* dst, int drow0, int ldd, const GF* sk, const GF* sn, float s, LAS float* scr, int lane, bool perm = false) {
    {
        const int r8 = lane >> 3, c4 = 4 * (lane & 7); f32x4 wv[8];
#pragma unroll
        for (int i = 0; i < 8; ++i) wv[i] = *(const Gf32x4*)(W + (size_t)(k0 + 8 * i + r8) * ldw + n0 + c4);
#pragma unroll
        for (int i = 0; i < 8; ++i) { LAS float* sp = scr + (8 * i + r8) * 33 + c4; sp[0] = wv[i][0]; sp[1] = wv[i][1]; sp[2] = wv[i][2]; sp[3] = wv[i][3]; }
    }
    asm volatile("s_waitcnt lgkmcnt(0)" ::: "memory");
    const int c = lane & 7;
    float skv[8];
#pragma unroll
    for (int q = 0; q < 8; ++q) skv[q] = sk ? sk[k0 + 8 * c + q] * s : s;
#pragma unroll
    for (int j = 0; j < 4; ++j) { const int n = (lane >> 3) + 8 * j; const LAS float* sp = scr + (8 * c) * 33 + n; const float f = sn ? sn[n0 + n] : 1.f;
        u32x4 o; o.x = pk2(sp[0 * 33] * skv[0] * f, sp[1 * 33] * skv[1] * f); o.y = pk2(sp[2 * 33] * skv[2] * f, sp[3 * 33] * skv[3] * f);
        o.z = pk2(sp[4 * 33] * skv[4] * f, sp[5 * 33] * skv[5] * f); o.w = pk2(sp[6 * 33] * skv[6] * f, sp[7 * 33] * skv[7] * f);
        const int nd = perm ? ((((n >> 2) & 1) << 4) | ((n >> 3) << 2) | (n & 3)) : n;
        *(Gu32x4*)(dst + (size_t)(drow0 + nd) * ldd + k0 + 8 * c) = o; }
    asm volatile("s_waitcnt lgkmcnt(0)" ::: "memory");
}
__device__ __forceinline__ int win_dest_row(int n) {
    if (n < 512) return n;
    if (n < 576) return 1536 + (n - 512);
    if (n < 1088) return 512 + (n - 576);
    if (n < 1600) return 1024 + (n - 1088);
    if (n < 2368) return 1792 + (n - 1600);
    if (n < 2880) return 2560 + (n - 2368);
    if (n < 3392) return 3072 + (n - 2880);
    return 3584 + (n - 3392);
}

__global__ void __launch_bounds__(NWAVES * 64, 2) fwd(Args args) {
    extern __shared__ __attribute__((aligned(16))) unsigned char lds_raw[];
    LAS unsigned char* lds = (LAS unsigned char*)lds_raw;
    volatile LAS unsigned* MISC = (volatile LAS unsigned*)(lds + MISC_OFF);
    const int G = gridDim.x, bid = blockIdx.x, NGW = G * NWAVES;
#define PHASE_IDS() int tid_ = threadIdx.x; asm volatile("" : "+v"(tid_)); const int tid = tid_, lane = tid & 63, wave = __builtin_amdgcn_readfirstlane(tid >> 6), gw = bid * NWAVES + wave; (void)lane; (void)gw
    unsigned* ctl0 = (unsigned*)(args.ws + WS_CTL);
    for (int u = threadIdx.x; u < (LDS_BYTES - LDSCTL_OFF) / 4; u += NWAVES * 64) ((LAS unsigned*)(lds + LDSCTL_OFF))[u] = 0u;
    __syncthreads();
    XcdBarrier bar; bar.bar = ctl0 + CW_BAR + args.region * XCD_BAR_WORDS; bar.x = 0; bar.st = nullptr;
    const int lo = args.ph_lo, hi = args.ph_hi;
    const bool multi = (hi - lo) > 1;
    if (multi) bar = xcd_barrier_post(ctl0 + CW_BAR + args.region * XCD_BAR_WORDS, MISC + 8);
#ifdef ONLY
#define IN(k) ((((k) < 2 ? 100 + (k) : ((k) - 2) % 10) == ONLY) && lo <= (k) && (k) < hi)
#elif defined(EXCL)
#define IN(k) ((((k) < 2 ? 100 + (k) : ((k) - 2) % 10) != EXCL) && lo <= (k) && (k) < hi)
#else
#define IN(k) (lo <= (k) && (k) < hi)
#endif
#define SEAM(k) do { if (IN((k) + 1)) xcd_barrier(bar); } while (0)
#define SEAM_MID() do { if (multi) xcd_barrier(bar); } while (0)

#define PHASE_PTRS() CKA* kp = (CKA*)__builtin_amdgcn_kernarg_segment_ptr(); asm volatile("" : "+s"(kp)); GC* ws = (GC*)*(const unsigned long long __attribute__((address_space(4)))*)(kp + 248); GU* ctl = (GU*)(ws + WS_CTL); (void)ctl
#define INP(i) ((const GF*)*(const unsigned long long __attribute__((address_space(4)))*)(kp + 8 * (i)))
#define WSP(T, off) ((GAS T*)(ws + (off)))
    enum { I_X = 0, I_C, I_CTX, I_CCTX, I_WADA, I_BADA, I_WIN, I_BGATE, I_GQ, I_GKV, I_WUQ, I_WUKV, I_LAM, I_GSUB, I_WPOOL, I_PSCALE, I_WBM, I_WBD, I_WBP, I_WO, I_LN1G, I_LN1B, I_WGRP, I_BGRP, I_WEXP, I_BEXP, I_WGU, I_WDN, I_LN2G, I_LN2B };
    if (IN(0)) {
        PHASE_PTRS(); PHASE_IDS();
        const GF* c_in = INP(I_C); const GF* cctx_in = INP(I_CCTX); const GF* w_ada = INP(I_WADA); const GF* b_ada = INP(I_BADA);
        GF* MOD = WSP(float, WS_MOD); GF* ROPEC = WSP(float, WS_ROPE); GF* ROPES = ROPEC + 1024;
        {
            LAS float* sl = (LAS float*)lds;
            LAS float* red = sl + 5 * 2048;
            for (int i = tid; i < 5 * 2048; i += 512) { const float v = i < 4 * 2048 ? c_in[i] : cctx_in[i - 4 * 2048]; sl[i] = v / (1.f + __expf(-v)); }
            __syncthreads();
            const int c4 = tid & 7, kg = tid >> 3;
            for (int unit = bid; unit < 384; unit += G) {
                const int l = 0, c0 = unit * 32;
                const GF* wp = w_ada + ((size_t)l * 2048 + kg) * 12288 + c0 + 4 * c4;
                f32x4 a0 = {0.f, 0.f, 0.f, 0.f}, a1 = a0, a2 = a0, a3 = a0, a4 = a0;
#pragma unroll 8
                for (int it = 0; it < 32; ++it) { const int k = kg + 64 * it; const f32x4 w = *(const Gf32x4*)(wp + (size_t)64 * it * 12288);
                    a0 += w * sl[k]; a1 += w * sl[2048 + k]; a2 += w * sl[4096 + k]; a3 += w * sl[6144 + k]; a4 += w * sl[8192 + k]; }
                *(LAS f32x4*)(red + (kg * 5 + 0) * 32 + 4 * c4) = a0; *(LAS f32x4*)(red + (kg * 5 + 1) * 32 + 4 * c4) = a1; *(LAS f32x4*)(red + (kg * 5 + 2) * 32 + 4 * c4) = a2;
                *(LAS f32x4*)(red + (kg * 5 + 3) * 32 + 4 * c4) = a3; *(LAS f32x4*)(red + (kg * 5 + 4) * 32 + 4 * c4) = a4;
                __syncthreads();
                if (tid < 160) { const int r = tid >> 5, col = tid & 31; float s = 0.f;
                    for (int q = 0; q < 64; ++q) s += red[(q * 5 + r) * 32 + col];
                    MOD[((size_t)l * 5 + r) * 12288 + c0 + col] = s + b_ada[(size_t)l * 12288 + c0 + col]; }
                __syncthreads();
            }
        }
        if (bid == 0 && tid < NL * 64) ctl[CW_CNT + tid] = 0u;
        if (bid == 0) for (int i = tid; i < 1024; i += 512) { const int pos = i >> 4, f = i & 15; const float inv = powf(10000.f, -(float)f / 16.f); const float ang = (float)pos * inv; ROPEC[i] = cosf(ang); ROPES[i] = sinf(ang); }
        for (int i = bid * 512 + tid; i < NL * 256 * 2048; i += G * 512) { const int l = i / (256 * 2048), r = i % (256 * 2048), cc = r / 2048, k = r % 2048;
            const float w = cc < 8 ? INP(I_WGRP)[((size_t)l * 2048 + k) * 8 + cc] : (cc < 72 ? INP(I_WEXP)[((size_t)l * 2048 + k) * 64 + (cc - 8)] : 0.f);
            const unsigned hi = f2bf(w); const float rem = w - __builtin_bit_cast(float, hi << 16);
            GB* wr = WSP(bf16_t, WS_WRT) + (size_t)l * 2 * 256 * 2048; wr[r] = (bf16_t)hi; wr[256 * 2048 + r] = (bf16_t)f2bf(rem); }
        for (int i = bid * 512 + tid; i < NL * 192 * 256; i += G * 512) { const int l = i / (192 * 256), r = i % (192 * 256); *(Gu32x4*)(WSP(bf16_t, WS_WIN) + ((size_t)l * NP + 1600) * 2048 + (size_t)r * 8) = (u32x4){0u, 0u, 0u, 0u}; }
        {
            LAS float* scr = (LAS float*)(lds + wave * 16384);
            constexpr int I_IN = 32 * 298, I_UKV = 8 * 64, I_UQ = 12 * 48, I_PL = 8 * 16, I_BM = 16 * 64, I_BD = 8 * 64, I_BP = 8 * 64, I_O = 32 * 64, I_GU = 0, I_DN = 0;
            constexpr int I_LAYER = I_IN + I_UKV + I_UQ + I_PL + I_BM + I_BD + I_BP + I_O + I_GU + I_DN;
            for (int it = gw; it < NL * I_LAYER; it += NGW) {
                const int l = it / I_LAYER; int r = it % I_LAYER;
                if (r < I_IN) { const int kb = r / 298, nb = r % 298, n0 = nb * 32; const float s = (n0 >= 2368 && n0 < 2880) ? 0.125f * LOG2E : 1.f;
                    cvt_item(INP(I_WIN) + (size_t)l * 2048 * IN_COLS, IN_COLS, kb * 64, n0, WSP(bf16_t, WS_WIN) + (size_t)l * NP * 2048, win_dest_row(n0) - 0, 2048, nullptr, nullptr, s, scr, lane, !((win_dest_row(n0) >= 512 && win_dest_row(n0) < 1024) || (win_dest_row(n0) >= 1536 && win_dest_row(n0) < 1792) || (win_dest_row(n0) >= 2560 && win_dest_row(n0) < 3072))); continue; } r -= I_IN;
                if (r < I_UKV) { const int kb = r / 64, nb = r % 64; cvt_item(INP(I_WUKV) + (size_t)l * 512 * 2048, 2048, kb * 64, nb * 32, WSP(bf16_t, WS_WUKV) + (size_t)l * 2048 * 512, nb * 32, 512, INP(I_GKV) + l * 512, nullptr, 1.f, scr, lane, true); continue; } r -= I_UKV;
                if (r < I_UQ) { const int kb = r / 48, nb = r % 48; cvt_item(INP(I_WUQ) + (size_t)l * 768 * 1536, 1536, kb * 64, nb * 32, WSP(bf16_t, WS_WUQ) + (size_t)l * 1536 * 768, nb * 32, 768, INP(I_GQ) + l * 768, nullptr, 0.07216878364870322f * LOG2E, scr, lane); continue; } r -= I_UQ;
                if (r < I_PL) { const int kb = r / 16, nb = r % 16, gk = kb >> 1, gn = nb >> 2;
                    if (gk == gn) cvt_item(INP(I_WPOOL) + ((size_t)l * 4 + gk) * 128 * 128, 128, (kb & 1) * 64, (nb & 3) * 32, WSP(bf16_t, WS_WPL) + (size_t)l * 512 * 512 + gk * 128, nb * 32, 512, nullptr, INP(I_PSCALE) + l * 512 + gn * 128, 1.f, scr, lane, true);
                    else { GB* dp = WSP(bf16_t, WS_WPL) + (size_t)l * 512 * 512 + (size_t)(nb * 32 + (lane >> 1)) * 512 + kb * 64 + (lane & 1) * 32;
#pragma unroll
                        for (int q = 0; q < 4; ++q) *(Gu32x4*)(dp + q * 8) = (u32x4){0u, 0u, 0u, 0u}; }
                    continue; } r -= I_PL;
                if (r < I_BM) { const int kb = r / 64, nb = r % 64; cvt_item(INP(I_WBM) + (size_t)l * 1024 * 2048, 2048, kb * 64, nb * 32, WSP(bf16_t, WS_WBM) + (size_t)l * 2048 * 1024, nb * 32, 1024, nullptr, nullptr, 1.f, scr, lane, true); continue; } r -= I_BM;
                if (r < I_BD) { const int kb = r / 64, nb = r % 64; cvt_item(INP(I_WBD) + (size_t)l * 512 * 2048, 2048, kb * 64, nb * 32, WSP(bf16_t, WS_WBD) + (size_t)l * 2048 * 512, nb * 32, 512, nullptr, nullptr, 1.f, scr, lane, true); continue; } r -= I_BD;
                if (r < I_BP) { const int kb = r / 64, nb = r % 64; cvt_item(INP(I_WBP) + (size_t)l * 512 * 2048, 2048, kb * 64, nb * 32, WSP(bf16_t, WS_WBP) + (size_t)l * 2048 * 512, nb * 32, 512, nullptr, nullptr, 1.f, scr, lane, true); continue; } r -= I_BP;
                if (r < I_O) { const int kb = r / 64, nb = r % 64; cvt_item(INP(I_WO) + (size_t)l * 2048 * 2048, 2048, kb * 64, nb * 32, WSP(bf16_t, WS_WO) + (size_t)l * 2048 * 2048, nb * 32, 2048, nullptr, nullptr, 1.f, scr, lane, true); continue; } r -= I_O;
            }
        }
        SEAM(0);
    }
    if (IN(1)) {
        PHASE_PTRS(); PHASE_IDS();
        const GF* x_in = INP(I_X); const GF* ctx_in = INP(I_CTX); const GF* MOD = WSP(float, WS_MOD); GB* U = WSP(bf16_t, WS_U);
        for (int pr = gw; pr < T / 2; pr += NGW) {
            const int row = 2 * pr;
            const GF* src = row < TL ? x_in + (size_t)row * 2048 : ctx_in + (size_t)(row - TL) * 2048; const int mrow = row < TL ? (row >> 11) : 4;
            const GF* md = MOD + (size_t)mrow * 12288;
            f32x4 v[2][8]; float sm[2] = {0.f, 0.f};
#pragma unroll
            for (int r = 0; r < 2; ++r)
#pragma unroll
                for (int j = 0; j < 8; ++j) v[r][j] = *(const Gf32x4*)(src + r * 2048 + (8 * lane + 512 * (j >> 1) + 4 * (j & 1)));
#pragma unroll
            for (int r = 0; r < 2; ++r)
#pragma unroll
                for (int j = 0; j < 8; ++j) { sm[r] += (v[r][j][0] + v[r][j][1]) + (v[r][j][2] + v[r][j][3]); }
            float rstd[2];
#pragma unroll
            for (int r = 0; r < 2; ++r) { const float mean = wave_sum(sm[r]) * (1.f / 2048.f); float s2 = 0.f;
#pragma unroll
                for (int j = 0; j < 8; ++j) { v[r][j] = v[r][j] - mean; s2 += (v[r][j][0] * v[r][j][0] + v[r][j][1] * v[r][j][1]) + (v[r][j][2] * v[r][j][2] + v[r][j][3] * v[r][j][3]); }
                rstd[r] = 1.f / sqrtf(wave_sum(s2) * (1.f / 2048.f) + EPS); }
#pragma unroll
            for (int j = 0; j < 8; j += 2) { const int c = (8 * lane + 512 * (j >> 1) + 4 * (j & 1)); const f32x4 sh = *(const Gf32x4*)(md + c), scv = *(const Gf32x4*)(md + 2048 + c) + 1.f, sw = *(const Gf32x4*)(md + c + 4), scw = *(const Gf32x4*)(md + 2048 + c + 4) + 1.f;
#pragma unroll
                for (int r = 0; r < 2; ++r) st8bf(U + (size_t)(row + r) * 2048 + c, v[r][j] * rstd[r] * scv + sh, v[r][j + 1] * rstd[r] * scw + sw); }
        }
        SEAM(1);
    }

    for (int l = 0; l < NL; ++l) {
        const int pb = 2 + 10 * l; const bool last = (l == NL - 1);
        const int nMall = last ? 32 : 36;
        const float lam_init = 0.8f - 0.6f * __expf(-0.3f * (float)l);
        if (IN(pb + 0)) {
            PHASE_PTRS(); PHASE_IDS();
            pg8::Plain g{WSP(bf16_t, WS_U), WSP(bf16_t, WS_WIN) + (size_t)l * NP * 2048, 2048, 2048, 2048};
            pg8::RectOrder S; if (last) S.init(32, 38, G, bid, 32, 4, 7); else S.init(36, 38, G, bid);
            EpiIn E{ws, INP(I_BGATE) + (size_t)l * 6144};
            pg8::gemm_phase<pg8::Plain, EpiIn, pg8::RectOrder>(lds, g, S, E);
            SEAM(pb + 0);
        }
        if (IN(pb + 1)) {
            PHASE_PTRS(); PHASE_IDS();
            const GB* PIN = WSP(bf16_t, WS_PIN); GB* PL = WSP(bf16_t, WS_PL);
            {
                const int nrows = nMall * 256;
                for (int i = bid * 512 + tid; i < nrows * 64; i += G * 512) {
                    const int row = i >> 6, c8 = (i & 63) * 8, gi = c8 >> 7, half = 1 << gi;
                    int t, s, base; if (row < TL) { t = row & 2047; s = 2048; base = row - t; } else { t = (row - TL) & 255; s = 256; base = row - t; }
                    const int lo_ = t - half < 0 ? 0 : t - half, hi_ = t + half > s ? s : t + half;
                    float a[8] = {0.f, 0.f, 0.f, 0.f, 0.f, 0.f, 0.f, 0.f};
                    for (int q = lo_; q < hi_; ++q) { const u32x4 w = *(const Gu32x4*)(PIN + (size_t)(base + q) * 512 + c8);
                        a[0] += bflo(w.x); a[1] += bfhi(w.x); a[2] += bflo(w.y); a[3] += bfhi(w.y); a[4] += bflo(w.z); a[5] += bfhi(w.z); a[6] += bflo(w.w); a[7] += bfhi(w.w); }
                    const float inv = 1.f / (float)(hi_ - lo_); const u32x4 w = *(const Gu32x4*)(PIN + (size_t)row * 512 + c8);
                    u32x4 o; o.x = pk2(a[0] * inv - bflo(w.x), a[1] * inv - bfhi(w.x)); o.y = pk2(a[2] * inv - bflo(w.y), a[3] * inv - bfhi(w.y));
                    o.z = pk2(a[4] * inv - bflo(w.z), a[5] * inv - bfhi(w.z)); o.w = pk2(a[6] * inv - bflo(w.w), a[7] * inv - bfhi(w.w));
                    *(Gu32x4*)(PL + (size_t)row * 512 + c8) = o;
                }
            }
            { pg8::Plain g{WSP(bf16_t, WS_CKV), WSP(bf16_t, WS_WUKV) + (size_t)l * 2048 * 512, 512, 512, 512}; pg8::RectOrder S; S.init(36, 8, G, bid);
              EpiKV E{WSP(bf16_t, WS_KN), WSP(bf16_t, WS_VM), WSP(float, WS_SSQKV)}; pg8::gemm_phase<pg8::Plain, EpiKV, pg8::RectOrder>(lds, g, S, E); }
            { pg8::Plain g{WSP(bf16_t, WS_CQ), WSP(bf16_t, WS_WUQ) + (size_t)l * 1536 * 768, 768, 768, 768}; pg8::RectOrder S; S.init(nMall, 6, G, bid); if ((G & 7) == 0 && G > nMall * 6) S.rot0 = (G - nMall * 6) & ~7;
              EpiQ E{WSP(bf16_t, WS_QM), WSP(float, WS_SSQQ), WSP(float, WS_ROPE), WSP(float, WS_ROPE) + 1024}; pg8::gemm_phase<pg8::Plain, EpiQ, pg8::RectOrder>(lds, g, S, E); }
            SEAM(pb + 1);
        }
        if (IN(pb + 2)) {
            PHASE_PTRS(); PHASE_IDS();
#ifndef NO_POOLG
            { pg8::Plain g{WSP(bf16_t, WS_PL), WSP(bf16_t, WS_WPL) + (size_t)l * 512 * 512, 512, 512, 512}; pg8::RectOrder S; S.init(nMall, 2, G, bid); if ((G & 7) == 0 && G > nMall * 2) S.rot0 = (G - nMall * 2) & ~7;
              EpiBf E{WSP(bf16_t, WS_OP), 512}; pg8::gemm_phase<pg8::Plain, EpiBf, pg8::RectOrder>(lds, g, S, E); }
#endif
            float lamv;
            { const GF* lp = INP(I_LAM) + (size_t)l * 256; const float sa = wave_sum(lp[lane] * lp[64 + lane]), sb = wave_sum(lp[128 + lane] * lp[192 + lane]); lamv = (expf(sa) - expf(sb)) + lam_init; }
#ifndef NO_MLA
            for (int un = bid; un < (last ? 256 : 288); un += G) {
                att::Args a; a.lamv = 0.f; a.osc = 0.f; a.gsub = INP(I_GSUB); a.KR = WSP(bf16_t, WS_KR); int b, h;
                if (un < 256) { b = un >> 6; h = (un >> 3) & 7; a.qrow0 = b * 2048 + (un & 7) * 256; a.nt = 36; }
                else { const int v = un - 256; b = v >> 3; h = v & 7; a.qrow0 = TL + b * 256; a.nt = 4; }
                a.nt_ctx = 4; a.ctx_row0 = TL + b * 256; a.lat_row0 = b * 2048;
                a.Q = WSP(bf16_t, WS_QM); a.ldq = 1536; a.qcol = h * 192; a.K = WSP(bf16_t, WS_KN); a.V = WSP(bf16_t, WS_VM); a.ldk = 1024; a.kcol = h * 128; a.O = WSP(bf16_t, WS_OM); a.ldo = 1024; a.ocol = h * 128;
                att::attn_unit<0>(a, lds);
            }
#endif
#ifndef NO_DIFF
            for (int un0 = bid; un0 < (last ? 256 : (G == 256 ? 320 : 288)); un0 += G) {
                int un = un0; if (G == 256 && un0 >= 256) { if (un0 < 288) continue; un = un0 - 32; }
                att::Args a; a.lamv = lamv; a.osc = 1.f - lam_init; a.gsub = INP(I_GSUB) + (size_t)l * 128; a.KR = WSP(bf16_t, WS_KR); int b, h;
                if (un < 256) { b = un >> 6; h = (un >> 4) & 3; a.qrow0 = b * 2048 + (un & 15) * 128; a.nt = 36; }
                else { const int v = un - 256; b = v >> 3; h = (v >> 1) & 3; a.qrow0 = TL + b * 256 + (v & 1) * 128; a.nt = 4; }
                a.nt_ctx = 4; a.ctx_row0 = TL + b * 256; a.lat_row0 = b * 2048;
                a.Q = WSP(bf16_t, WS_QD); a.ldq = 512; a.qcol = h * 128; a.K = WSP(bf16_t, WS_KD); a.V = WSP(bf16_t, WS_VD); a.ldk = 512; a.kcol = h * 128; a.O = WSP(bf16_t, WS_OD); a.ldo = 512; a.ocol = h * 128;
                att::attn_unit<1>(a, lds);
            }
#endif
            SEAM(pb + 2);
        }
        if (IN(pb + 3)) {
            PHASE_PTRS(); PHASE_IDS();
            GB* MG = WSP(bf16_t, WS_MG); const GB* GT = WSP(bf16_t, WS_GT);
            pg8::RectOrder S; S.init(nMall, 8, G, bid); GU* flg = ctl + CW_FLG + l * 2048;
            const int rstep = (G >= 192 && (G & 7) == 0) ? 64 : 0;
            { pg8::Plain g{WSP(bf16_t, WS_OM), WSP(bf16_t, WS_WBM) + (size_t)l * 2048 * 1024, 1024, 1024, 1024}; EpiMerge<0> E{MG, GT, flg, (LAS unsigned*)(lds + mg::TAB_OFF + 2048)}; pg8::gemm_phase<pg8::Plain, EpiMerge<0>, pg8::RectOrder>(lds, g, S, E); }
            S.rot = rstep;
            { pg8::Plain g{WSP(bf16_t, WS_OD), WSP(bf16_t, WS_WBD) + (size_t)l * 2048 * 512, 512, 512, 512}; EpiMerge<1> E{MG, GT, flg, (LAS unsigned*)(lds + mg::TAB_OFF + 2048)}; pg8::gemm_phase<pg8::Plain, EpiMerge<1>, pg8::RectOrder>(lds, g, S, E); }
            S.rot = 2 * rstep;
            { pg8::Plain g{WSP(bf16_t, WS_OP), WSP(bf16_t, WS_WBP) + (size_t)l * 2048 * 512, 512, 512, 512}; EpiMerge<2> E{MG, GT, flg, (LAS unsigned*)(lds + mg::TAB_OFF + 2048)}; pg8::gemm_phase<pg8::Plain, EpiMerge<2>, pg8::RectOrder>(lds, g, S, E); }
            SEAM(pb + 3);
        }
        if (IN(pb + 4)) {
            PHASE_PTRS(); PHASE_IDS();
            pg8::Plain g{WSP(bf16_t, WS_MG), WSP(bf16_t, WS_WO) + (size_t)l * 2048 * 2048, 2048, 2048, 2048}; pg8::RectOrder S; S.init(nMall, 8, G, bid);
            EpiWo E{WSP(bf16_t, WS_XS), WSP(float, WS_MOD) + (size_t)l * 5 * 12288, INP(I_X), INP(I_CTX) - (size_t)TL * 2048, l == 0}; pg8::gemm_phase<pg8::Plain, EpiWo, pg8::RectOrder>(lds, g, S, E);
            if (!last) {
                const int nx = nMall * 8 - G, pfirst = (nx > 0 && nx < G) ? nx : 0, pn = G - pfirst;
                if (bid >= pfirst) {
                    const GF* c_in = INP(I_C); const GF* cctx_in = INP(I_CCTX); const GF* w_ada = INP(I_WADA); const GF* b_ada = INP(I_BADA); GF* MOD = WSP(float, WS_MOD);
                    LAS float* sl = (LAS float*)lds;
                    LAS float* red = sl + 5 * 2048;
                    for (int i = tid; i < 5 * 2048; i += 512) { const float v = i < 4 * 2048 ? c_in[i] : cctx_in[i - 4 * 2048]; sl[i] = v / (1.f + __expf(-v)); }
                    __syncthreads();
                    const int c4 = tid & 7, kg = tid >> 3, l1 = l + 1;
                    for (int unit = bid - pfirst; unit < 384; unit += pn) {
                        const int c0 = unit * 32;
                        const GF* wp = w_ada + ((size_t)l1 * 2048 + kg) * 12288 + c0 + 4 * c4;
                        f32x4 a0 = {0.f, 0.f, 0.f, 0.f}, a1 = a0, a2 = a0, a3 = a0, a4 = a0;
#pragma unroll 8
                        for (int it = 0; it < 32; ++it) { const int k = kg + 64 * it; const f32x4 w = *(const Gf32x4*)(wp + (size_t)64 * it * 12288);
                            a0 += w * sl[k]; a1 += w * sl[2048 + k]; a2 += w * sl[4096 + k]; a3 += w * sl[6144 + k]; a4 += w * sl[8192 + k]; }
                        *(LAS f32x4*)(red + (kg * 5 + 0) * 32 + 4 * c4) = a0; *(LAS f32x4*)(red + (kg * 5 + 1) * 32 + 4 * c4) = a1; *(LAS f32x4*)(red + (kg * 5 + 2) * 32 + 4 * c4) = a2;
                        *(LAS f32x4*)(red + (kg * 5 + 3) * 32 + 4 * c4) = a3; *(LAS f32x4*)(red + (kg * 5 + 4) * 32 + 4 * c4) = a4;
                        __syncthreads();
                        if (tid < 160) { const int r = tid >> 5, col = tid & 31; float sm_ = 0.f;
                            for (int q = 0; q < 64; ++q) sm_ += red[(q * 5 + r) * 32 + col];
                            MOD[((size_t)l1 * 5 + r) * 12288 + c0 + col] = sm_ + b_ada[(size_t)l1 * 12288 + c0 + col]; }
                        __syncthreads();
                    }
                }
            }
            SEAM(pb + 4);
        }
        if (IN(pb + 5)) {
            PHASE_PTRS(); PHASE_IDS();
            const GF* modl = WSP(float, WS_MOD) + (size_t)l * 5 * 12288; const GB* XS = WSP(bf16_t, WS_XS); GB* VB = WSP(bf16_t, WS_VB); GI* TOPK = WSP(int, WS_TOPK);
            const GF* ln1_g = INP(I_LN1G); const GF* ln1_b = INP(I_LN1B); const GF* b_grp = INP(I_BGRP); const GF* b_exp = INP(I_BEXP);
            const int nrows = nMall * 256; GB* VLO = WSP(bf16_t, WS_VLO);
            for (int pr = gw; pr < nrows / 2; pr += NGW) {
                const int row = 2 * pr; const int mrow = row < TL ? (row >> 11) : 4; const GF* md = modl + (size_t)mrow * 12288;
                f32x4 v[2][8]; float sm[2] = {0.f, 0.f}, rstd[2];
#pragma unroll
                for (int r = 0; r < 2; ++r)
#pragma unroll
                    for (int j = 0; j < 8; ++j) v[r][j] = ld4bf(XS + (size_t)(row + r) * 2048 + (8 * lane + 512 * (j >> 1) + 4 * (j & 1)));
#pragma unroll
                for (int r = 0; r < 2; ++r) {
#pragma unroll
                    for (int j = 0; j < 8; ++j) sm[r] += (v[r][j][0] + v[r][j][1]) + (v[r][j][2] + v[r][j][3]);
                    const float mean = wave_sum(sm[r]) * (1.f / 2048.f); float s2 = 0.f;
#pragma unroll
                    for (int j = 0; j < 8; ++j) { v[r][j] = v[r][j] - mean; s2 += (v[r][j][0] * v[r][j][0] + v[r][j][1] * v[r][j][1]) + (v[r][j][2] * v[r][j][2] + v[r][j][3] * v[r][j][3]); }
                    rstd[r] = 1.f / sqrtf(wave_sum(s2) * (1.f / 2048.f) + EPS); sm[r] = 0.f;
                    if (lane == 0) { GF* stp = WSP(float, WS_SSQKV) + (size_t)(row + r) * 8; stp[0] = mean; stp[1] = rstd[r]; } }
#pragma unroll
                for (int j = 0; j < 8; ++j) { const int c = (8 * lane + 512 * (j >> 1) + 4 * (j & 1)); const f32x4 gg = *(const Gf32x4*)(ln1_g + l * 2048 + c), bb = *(const Gf32x4*)(ln1_b + l * 2048 + c);
#pragma unroll
                    for (int r = 0; r < 2; ++r) { v[r][j] = v[r][j] * rstd[r] * gg + bb; sm[r] += (v[r][j][0] + v[r][j][1]) + (v[r][j][2] + v[r][j][3]); } }
#pragma unroll
                for (int r = 0; r < 2; ++r) { const float mean = wave_sum(sm[r]) * (1.f / 2048.f); float s2 = 0.f;
#pragma unroll
                    for (int j = 0; j < 8; ++j) { v[r][j] = v[r][j] - mean; s2 += (v[r][j][0] * v[r][j][0] + v[r][j][1] * v[r][j][1]) + (v[r][j][2] * v[r][j][2] + v[r][j][3] * v[r][j][3]); }
                    rstd[r] = 1.f / sqrtf(wave_sum(s2) * (1.f / 2048.f) + EPS); }
#pragma unroll
                for (int j = 0; j < 8; j += 2) { const int c = (8 * lane + 512 * (j >> 1) + 4 * (j & 1)); const f32x4 scv = *(const Gf32x4*)(md + 4 * 2048 + c) + 1.f, sh = *(const Gf32x4*)(md + 3 * 2048 + c), scw = *(const Gf32x4*)(md + 4 * 2048 + c + 4) + 1.f, sw = *(const Gf32x4*)(md + 3 * 2048 + c + 4);
#pragma unroll
                    for (int r = 0; r < 2; ++r) { const f32x4 x = v[r][j] * rstd[r] * scv + sh, y = v[r][j + 1] * rstd[r] * scw + sw; st8bf(VB + (size_t)(row + r) * 2048 + c, x, y);
                        f32x4 lo_, lp_;
#pragma unroll
                        for (int q = 0; q < 4; ++q) { lo_[q] = x[q] - __builtin_bit_cast(float, f2bf(x[q]) << 16); lp_[q] = y[q] - __builtin_bit_cast(float, f2bf(y[q]) << 16); }
                        st8bf(VLO + (size_t)(row + r) * 2048 + c, lo_, lp_); } }
            }
            SEAM_MID();
            { RouterP g{VB, WSP(bf16_t, WS_VLO), WSP(bf16_t, WS_WRT) + (size_t)l * 2 * 256 * 2048, WSP(bf16_t, WS_WRT) + ((size_t)l * 2 + 1) * 256 * 2048, 1024, 2048, 2048};
              SliceOrder S{nMall, G, bid}; EpiRouter E{WSP(float, WS_RP)}; pg8::gemm_phase<RouterP, EpiRouter, SliceOrder>(lds, g, S, E); }
            SEAM_MID();
            LAS unsigned* lcnt = (LAS unsigned*)lds;
            if (tid < 64) lcnt[tid] = 0u;
            __syncthreads();
            for (int row = gw; row < nrows; row += NGW) {
                const GF* rp = WSP(float, WS_RP) + (size_t)row * 80; float lg = 0.f, le = 0.f;
#pragma unroll
                for (int q = 0; q < 6; ++q) { le += rp[(size_t)q * T * 80 + 8 + lane]; if (lane < 8) lg += rp[(size_t)q * T * 80 + lane]; }
                if (lane < 8) lg += b_grp[l * 8 + lane];
                le += b_exp[l * 64 + lane];
                float gl[8];
#pragma unroll
                for (int q = 0; q < 8; ++q) gl[q] = __shfl(lg, q);
                int gi = 0; float gm = gl[0];
#pragma unroll
                for (int q = 1; q < 8; ++q) if (gl[q] > gm) { gm = gl[q]; gi = q; }
                float gs = 0.f;
#pragma unroll
                for (int q = 0; q < 8; ++q) gs += expf(gl[q] - gm);
                const float grp_p = 1.f / gs;
                float el[8];
#pragma unroll
                for (int q = 0; q < 8; ++q) el[q] = __shfl(le, gi * 8 + q);
                int i1 = 0; float v1 = el[0];
#pragma unroll
                for (int q = 1; q < 8; ++q) if (el[q] > v1) { v1 = el[q]; i1 = q; }
                int i2 = -1; float v2 = -3.4e38f;
#pragma unroll
                for (int q = 0; q < 8; ++q) if (q != i1 && el[q] > v2) { v2 = el[q]; i2 = q; }
                const float e2 = expf(v2 - v1), w0 = grp_p / (1.f + e2), w1 = grp_p * e2 / (1.f + e2);
                if (lane == 0) { const int e0 = gi * 8 + i1, e1 = gi * 8 + i2;
                    const int p0 = (int)__hip_atomic_fetch_add(lcnt + e0, 1u, __ATOMIC_RELAXED, __HIP_MEMORY_SCOPE_WORKGROUP), p1 = (int)__hip_atomic_fetch_add(lcnt + e1, 1u, __ATOMIC_RELAXED, __HIP_MEMORY_SCOPE_WORKGROUP);
                    GI* tk = TOPK + (size_t)row * 8; tk[0] = e0; tk[1] = e1; ((GF*)tk)[2] = w0; ((GF*)tk)[3] = w1; tk[4] = p0; tk[5] = p1; }
            }
            __syncthreads();
            if (tid < 64) ctl[CW_HIST + (l * 512 + bid) * 64 + tid] = lcnt[tid];
            __syncthreads();
            SEAM(pb + 5);
        }
        if (IN(pb + 6)) {
            PHASE_PTRS(); PHASE_IDS();
            GI* TE = WSP(int, WS_TE) + l * 256; GI* TV = WSP(int, WS_TE) + 512 + l * 128; GI* TOPK = WSP(int, WS_TOPK); GI* S2T = WSP(int, WS_XG);
            LAS int* soff = (LAS int*)lds;
            LAS int* tot = soff + 64;
            {
                LAS int* part = soff + 256;
                const int e_ = tid & 63, q_ = tid >> 6, b_lo = (G * q_) >> 3, b_hi = (G * (q_ + 1)) >> 3; int pre = 0, t_ = 0;
#pragma unroll 8
                for (int b2 = b_lo; b2 < b_hi; ++b2) { const int cn = (int)ctl[CW_HIST + (l * 512 + b2) * 64 + e_]; pre += b2 < bid ? cn : 0; t_ += cn; }
                part[q_ * 64 + e_] = pre; part[512 + q_ * 64 + e_] = t_;
                __syncthreads();
                if (tid < 64) { int a = 0, b = 0;
#pragma unroll
                    for (int q = 0; q < 8; ++q) { a += part[q * 64 + tid]; b += part[512 + q * 64 + tid]; }
                    soff[tid] = a; tot[tid] = b; }
                __syncthreads();
            }
            LAS int* stf = soff + 128;
            if (tid < 64) {
                const int te_ = tot[tid], nt_ = (te_ + STROWS - 1) / STROWS; int incl = nt_;
#pragma unroll
                for (int d = 1; d < 64; d <<= 1) { const int v_ = __shfl_up(incl, d); if (lane >= d) incl += v_; }
                const int first = incl - nt_; stf[tid] = first;
                if (bid == 0) { for (int q = 0; q < nt_; ++q) { TE[first + q] = tid; const int rem = te_ - STROWS * q; TV[first + q] = rem < STROWS ? rem : STROWS; }
                    if (tid == 63) TE[200] = incl; } }
            __syncthreads();
            const int nrows = nMall * 256;
            for (int row = (tid >> 3) * NGW + bid * NWAVES + (tid & 7); row < nrows; row += 64 * NGW) {
                GI* tk = TOPK + (size_t)row * 8; const int e0 = tk[0], e1 = tk[1], p0 = soff[e0] + tk[4], p1 = soff[e1] + tk[5], s0 = (stf[e0] + p0 / STROWS) * 512 + p0 % STROWS, s1 = (stf[e1] + p1 / STROWS) * 512 + p1 % STROWS;
                tk[6] = s0; tk[7] = s1; S2T[s0] = row; S2T[s1] = row;
            }
            __syncthreads();
            SEAM(pb + 6);
        }
        if (IN(pb + 7)) {
            PHASE_PTRS(); PHASE_IDS();
            const GI* TE = WSP(int, WS_TE) + l * 256;
            mg::moe_gemm<0>(lds, WSP(bf16_t, WS_VB), INP(I_WGU) + (size_t)l * NEXP * 2048 * 1024, WSP(bf16_t, WS_HB), TE, WSP(int, WS_TE) + 512 + l * 128, WSP(int, WS_XG), __hip_atomic_load(TE + 200, __ATOMIC_RELAXED, __HIP_MEMORY_SCOPE_AGENT), G, bid);
            SEAM(pb + 7);
        }
        if (IN(pb + 8)) {
            PHASE_PTRS(); PHASE_IDS();
            const GI* TE = WSP(int, WS_TE) + l * 256;
            mg::moe_gemm<1>(lds, WSP(bf16_t, WS_HB), INP(I_WDN) + (size_t)l * NEXP * 512 * 2048, WSP(bf16_t, WS_YB), TE, WSP(int, WS_TE) + 512 + l * 128, WSP(int, WS_XG), __hip_atomic_load(TE + 200, __ATOMIC_RELAXED, __HIP_MEMORY_SCOPE_AGENT), G, bid);
            SEAM(pb + 8);
        }
        if (IN(pb + 9)) {
            PHASE_PTRS(); PHASE_IDS();
            const GF* MOD = WSP(float, WS_MOD); const GF* modl = MOD + (size_t)l * 5 * 12288; GB* XS = WSP(bf16_t, WS_XS); GB* U = WSP(bf16_t, WS_U); const GI* TOPK = WSP(int, WS_TOPK); const GB* YB = WSP(bf16_t, WS_YB);
            const GF* ln2_g = INP(I_LN2G); const GF* ln2_b = INP(I_LN2B); GF* outp = (GF*)*(const unsigned long long __attribute__((address_space(4)))*)(kp + 240);
            const int nrows = nMall * 256;
            for (int pr = gw; pr < nrows / 2; pr += NGW) {
                const int row = 2 * pr; const int mrow = row < TL ? (row >> 11) : 4; const GF* md = modl + (size_t)mrow * 12288;
                float w0[2], w1[2]; int s0[2], s1[2];
#pragma unroll
                for (int r = 0; r < 2; ++r) { const GI* tk = TOPK + (size_t)(row + r) * 8; w0[r] = ((const GF*)tk)[2]; w1[r] = ((const GF*)tk)[3]; s0[r] = tk[6]; s1[r] = tk[7]; }
                float mu1[2], rs1[2];
#pragma unroll
                for (int r = 0; r < 2; ++r) { const GF* stp = WSP(float, WS_SSQKV) + (size_t)(row + r) * 8; mu1[r] = stp[0]; rs1[r] = stp[1]; }
                f32x4 v[2][8]; float sm[2] = {0.f, 0.f}, rstd[2];
#pragma unroll
                for (int j = 0; j < 8; ++j) { const int c = (8 * lane + 512 * (j >> 1) + 4 * (j & 1)); const f32x4 g2 = *(const Gf32x4*)(md + 5 * 2048 + c), gg1 = *(const Gf32x4*)(INP(I_LN1G) + l * 2048 + c), bb1 = *(const Gf32x4*)(INP(I_LN1B) + l * 2048 + c);
#pragma unroll
                    for (int r = 0; r < 2; ++r) { const f32x4 y = ld4bf(YB + (size_t)s0[r] * 2048 + c) * w0[r] + ld4bf(YB + (size_t)s1[r] * 2048 + c) * w1[r];
                        v[r][j] = ((ld4bf(XS + (size_t)(row + r) * 2048 + c) - mu1[r]) * rs1[r] * gg1 + bb1) * DN_ALPHA + g2 * y; sm[r] += (v[r][j][0] + v[r][j][1]) + (v[r][j][2] + v[r][j][3]); } }
#pragma unroll
                for (int r = 0; r < 2; ++r) { const float mean = wave_sum(sm[r]) * (1.f / 2048.f); float s2 = 0.f;
#pragma unroll
                    for (int j = 0; j < 8; ++j) { v[r][j] = v[r][j] - mean; s2 += (v[r][j][0] * v[r][j][0] + v[r][j][1] * v[r][j][1]) + (v[r][j][2] * v[r][j][2] + v[r][j][3] * v[r][j][3]); }
                    rstd[r] = 1.f / sqrtf(wave_sum(s2) * (1.f / 2048.f) + EPS); sm[r] = 0.f; }
#pragma unroll
                for (int j = 0; j < 8; ++j) { const int c = (8 * lane + 512 * (j >> 1) + 4 * (j & 1)); const f32x4 gg = *(const Gf32x4*)(ln2_g + l * 2048 + c), bb = *(const Gf32x4*)(ln2_b + l * 2048 + c);
#pragma unroll
                    for (int r = 0; r < 2; ++r) { v[r][j] = v[r][j] * rstd[r] * gg + bb; sm[r] += (v[r][j][0] + v[r][j][1]) + (v[r][j][2] + v[r][j][3]);
                        if (last) *(Gf32x4*)(outp + (size_t)(row + r) * 2048 + c) = v[r][j]; else if (j & 1) st8bf(XS + (size_t)(row + r) * 2048 + c - 4, v[r][j - 1], v[r][j]); } }
                if (!last) {
                    const GF* mn = MOD + ((size_t)(l + 1) * 5 + mrow) * 12288;
#pragma unroll
                    for (int r = 0; r < 2; ++r) { const float mean = wave_sum(sm[r]) * (1.f / 2048.f); float s2 = 0.f;
#pragma unroll
                        for (int j = 0; j < 8; ++j) { v[r][j] = v[r][j] - mean; s2 += (v[r][j][0] * v[r][j][0] + v[r][j][1] * v[r][j][1]) + (v[r][j][2] * v[r][j][2] + v[r][j][3] * v[r][j][3]); }
                        rstd[r] = 1.f / sqrtf(wave_sum(s2) * (1.f / 2048.f) + EPS); }
#pragma unroll
                    for (int j = 0; j < 8; j += 2) { const int c = (8 * lane + 512 * (j >> 1) + 4 * (j & 1)); const f32x4 scv = *(const Gf32x4*)(mn + 2048 + c) + 1.f, sh = *(const Gf32x4*)(mn + c), scw = *(const Gf32x4*)(mn + 2048 + c + 4) + 1.f, sw = *(const Gf32x4*)(mn + c + 4);
#pragma unroll
                        for (int r = 0; r < 2; ++r) st8bf(U + (size_t)(row + r) * 2048 + c, v[r][j] * rstd[r] * scv + sh, v[r][j + 1] * rstd[r] * scw + sw); }
                }
            }
            SEAM(pb + 9);
        }
    }
#undef IN
#undef SEAM
}


extern "C" void kernel_launch(void* const* d_in, const int* in_sizes, int n_in, void* d_out, int out_size, void* d_ws, size_t ws_size, hipStream_t stream) {
    static int grid = 0;
    if (grid == 0) {
        if (n_in != 30 || out_size != TL * D || ws_size < WS_END) { fprintf(stderr, "kernel_launch: unexpected shapes (n_in %d out %d ws %zu need %zu)\n", n_in, out_size, ws_size, (size_t)WS_END); grid = -1; return; }
        int dev = 0, cus = 0, per_cu = 0;
        if (hipGetDevice(&dev) != hipSuccess || hipDeviceGetAttribute(&cus, hipDeviceAttributeMultiprocessorCount, dev) != hipSuccess) { grid = -1; return; }
        if (hipFuncSetAttribute((const void*)fwd, hipFuncAttributeMaxDynamicSharedMemorySize, LDS_BYTES) != hipSuccess) { fprintf(stderr, "kernel_launch: hipFuncSetAttribute failed\n"); grid = -1; return; }
        if (hipOccupancyMaxActiveBlocksPerMultiprocessor(&per_cu, (const void*)fwd, NWAVES * 64, LDS_BYTES) != hipSuccess || per_cu < 1) fprintf(stderr, "kernel_launch: occupancy query reports %d\n", per_cu);
        (void)hipGetLastError();
        grid = cus;
    }
    if (grid < 0) return;
    (void)hipMemsetAsync((char*)d_ws + WS_CTL, 0, CTL_BYTES, stream);
    Args a{};
    for (int i = 0; i < 30; ++i) a.in[i] = (const float*)d_in[i];
    a.out = (float*)d_out; a.ws = (unsigned char*)d_ws;
#if MK_N_LAUNCHES == 1
#if defined(DBG_PREFIX)
    a.ph_lo = 0; a.ph_hi = DBG_PREFIX; a.region = 1; hipLaunchKernelGGL(fwd, dim3(grid), dim3(NWAVES * 64), LDS_BYTES, stream, a);
#endif
    a.ph_lo = 0; a.ph_hi = NPHASE; a.region = 0;
    hipLaunchKernelGGL(fwd, dim3(grid), dim3(NWAVES * 64), LDS_BYTES, stream, a);
#else
    for (int p = 0; p < NPHASE; ++p) { a.ph_lo = p; a.ph_hi = p + 1; hipLaunchKernelGGL(fwd, dim3(grid), dim3(NWAVES * 64), LDS_BYTES, stream, a); }
#endif
    const hipError_t le = hipPeekAtLastError();
    if (le != hipSuccess) fprintf(stderr, "kernel_launch: launch failed: %s\n", hipGetErrorName(le));
}
```
